# Optimizing an MI355X kernel written in HIP

```python
import math
import jax, jax.numpy as jnp
from jax import lax
import numpy as np

D_MODEL = 1024
BATCH = 8
SEQ = 8192
DEPTH = 2

HEAD_DIM = 64
Q_BLOCK = 128
RMS_EPS = 1e-6
FOX_HEADS = 8
DSA_HEADS = 8
IDX_HEADS = 4
IDX_DIM = 64
DSA_TOPK = 256
DIFF_HEADS = 4
DIFF_VDIM = 2 * HEAD_DIM
MLA_HEADS = 8
MLA_NOPE = 64
MLA_ROPE = 32
MLA_VDIM = 64
MLA_Q_RANK = 256
MLA_KV_RANK = 128
ROPE_THETA = 10000.0
T5_BUCKETS = 32
T5_MAX_DIST = 128
T5_HEADS = 8
FFN_HIDDEN = 256 * math.ceil(8 * D_MODEL / (3 * 256))

FOX_W = FOX_HEADS * HEAD_DIM
DSA_W = DSA_HEADS * HEAD_DIM
EVEN_SPLITS = [FOX_W, FOX_W, FOX_W, FOX_HEADS, DSA_W, DSA_W, DSA_W,
               IDX_HEADS * IDX_DIM, IDX_DIM, IDX_HEADS]
EVEN_IN = sum(EVEN_SPLITS)
EVEN_MIX = FOX_W + DSA_W
DIFF_QK_W = DIFF_HEADS * 2 * HEAD_DIM
DIFF_V_W = DIFF_HEADS * DIFF_VDIM
MLA_OUT_W = MLA_HEADS * MLA_VDIM
ODD_SPLITS = [DIFF_QK_W, DIFF_QK_W, DIFF_V_W, MLA_Q_RANK, MLA_KV_RANK, MLA_ROPE]
ODD_IN = sum(ODD_SPLITS)
ODD_MIX = DIFF_V_W + MLA_OUT_W
N_EVEN = (DEPTH + 1) // 2
N_ODD = DEPTH // 2

kernel_name = "hybrid_fox_dsa_diff_mla_block"

F32 = jnp.float32


def rms_norm(x, g):
    x32 = x.astype(F32)
    y = x32 * lax.rsqrt(jnp.mean(x32 * x32, axis=-1, keepdims=True) + RMS_EPS)
    return (y * g.astype(F32)).astype(x.dtype)


def split_cols(y, sizes):
    offs = [int(o) for o in np.cumsum(sizes)[:-1]]
    return jnp.split(y, offs, axis=-1)


def causal_mask(t_pos, s_len):
    return jnp.arange(s_len)[None, :] <= t_pos[:, None]


def masked_softmax(logits, mask):
    return jax.nn.softmax(jnp.where(mask, logits, -jnp.inf), axis=-1)


def t5_bucket(dist):
    exact = T5_BUCKETS // 2
    d = jnp.maximum(dist, 1).astype(F32)
    log_b = exact + (jnp.log(d / exact) / math.log(T5_MAX_DIST / exact)
                     * (T5_BUCKETS - exact)).astype(jnp.int32)
    log_b = jnp.minimum(log_b, T5_BUCKETS - 1)
    return jnp.where(dist < exact, dist, log_b)


def dense_t5_bias(t_pos, s_len, table):
    dist = jnp.maximum(t_pos[:, None] - jnp.arange(s_len)[None, :], 0)
    return jnp.transpose(table[t5_bucket(dist)], (2, 0, 1)).astype(F32)


def sweep_query_blocks(block_fn, seq_len):
    n = seq_len // Q_BLOCK
    out = lax.map(block_fn, jnp.arange(n))
    out = jnp.moveaxis(out, 0, 1)
    return out.reshape(out.shape[0], n * Q_BLOCK, *out.shape[3:])


def rope_tables(s_len):
    pos = jnp.arange(s_len, dtype=F32)
    inv = ROPE_THETA ** (-jnp.arange(0, MLA_ROPE, 2, dtype=F32) / MLA_ROPE)
    ang = pos[:, None] * inv[None, :]
    ang = jnp.concatenate([ang, ang], axis=-1)
    return jnp.cos(ang), jnp.sin(ang)


def apply_rope(x, cos, sin):
    x32 = x.astype(F32)
    x1, x2 = jnp.split(x32, 2, axis=-1)
    rot = jnp.concatenate([-x2, x1], axis=-1)
    return (x32 * cos + rot * sin).astype(x.dtype)


def fox_attention(q, k, v, log_cum):
    s_len = q.shape[1]
    scale = HEAD_DIM ** -0.5

    def block(i):
        start = i * Q_BLOCK
        t_pos = start + jnp.arange(Q_BLOCK)
        qb = lax.dynamic_slice_in_dim(q, start, Q_BLOCK, 1)
        cb = lax.dynamic_slice_in_dim(log_cum, start, Q_BLOCK, 2)
        logits = jnp.einsum('bqhd,bkhd->bhqk', qb, k, preferred_element_type=F32) * scale
        logits = logits + (cb[..., None] - log_cum[:, :, None, :])
        p = masked_softmax(logits, causal_mask(t_pos, s_len))
        return jnp.einsum('bhqk,bkhd->bqhd', p.astype(v.dtype), v)

    return sweep_query_blocks(block, s_len)


def dsa_attention(q, k, v, q_idx, k_idx, w_idx, t5_table):
    s_len = q.shape[1]
    k_sel = min(DSA_TOPK, s_len // 4)
    scale = HEAD_DIM ** -0.5
    idx_scale = (IDX_DIM ** -0.5) * (IDX_HEADS ** -0.5)
    gather = jax.vmap(lambda a, ix: a[ix])

    def block(i):
        start = i * Q_BLOCK
        t_pos = start + jnp.arange(Q_BLOCK)
        qb = lax.dynamic_slice_in_dim(q, start, Q_BLOCK, 1)
        qib = lax.dynamic_slice_in_dim(q_idx, start, Q_BLOCK, 1)
        wb = lax.dynamic_slice_in_dim(w_idx, start, Q_BLOCK, 1)
        rel = jax.nn.relu(jnp.einsum('bqhd,bkd->bqhk', qib, k_idx, preferred_element_type=F32))
        score = jnp.einsum('bqhk,bqh->bqk', rel, wb.astype(F32)) * idx_scale
        score = jnp.where(causal_mask(t_pos, s_len)[None], score, -jnp.inf)
        _, sel = lax.top_k(score, k_sel)
        valid = sel <= t_pos[None, :, None]
        ks = gather(k, sel)
        vs = gather(v, sel)
        logits = jnp.einsum('bqhd,bqkhd->bhqk', qb, ks, preferred_element_type=F32) * scale
        dist = jnp.maximum(t_pos[None, :, None] - sel, 0)
        bias = t5_table[t5_bucket(dist)]
        logits = logits + jnp.transpose(bias, (0, 3, 1, 2)).astype(F32)
        p = masked_softmax(logits, valid[:, None])
        return jnp.einsum('bhqk,bqkhd->bqhd', p.astype(vs.dtype), vs)

    return sweep_query_blocks(block, s_len)


def diff_attention(q, k, v, lam, t5_table):
    bsz, s_len = q.shape[:2]
    scale = HEAD_DIM ** -0.5

    def block(i):
        start = i * Q_BLOCK
        t_pos = start + jnp.arange(Q_BLOCK)
        qb = lax.dynamic_slice_in_dim(q, start, Q_BLOCK, 1)
        logits = jnp.einsum('bqhd,bkhd->bhqk', qb, k, preferred_element_type=F32) * scale
        logits = logits + dense_t5_bias(t_pos, s_len, t5_table)[None]
        p = masked_softmax(logits, causal_mask(t_pos, s_len))
        p = p.reshape(bsz, DIFF_HEADS, 2, Q_BLOCK, s_len)
        a = p[:, :, 0] - lam * p[:, :, 1]
        return jnp.einsum('bhqk,bkhd->bqhd', a.astype(v.dtype), v)

    return sweep_query_blocks(block, s_len)


def mla_attention(q_nope, q_rope, k_nope, k_rope, v):
    s_len = q_nope.shape[1]
    scale = (MLA_NOPE + MLA_ROPE) ** -0.5

    def block(i):
        start = i * Q_BLOCK
        t_pos = start + jnp.arange(Q_BLOCK)
        qn = lax.dynamic_slice_in_dim(q_nope, start, Q_BLOCK, 1)
        qr = lax.dynamic_slice_in_dim(q_rope, start, Q_BLOCK, 1)
        logits = (jnp.einsum('bqhd,bkhd->bhqk', qn, k_nope, preferred_element_type=F32)
                  + jnp.einsum('bqhr,bkr->bhqk', qr, k_rope, preferred_element_type=F32)) * scale
        p = masked_softmax(logits, causal_mask(t_pos, s_len))
        return jnp.einsum('bhqk,bkhd->bqhd', p.astype(v.dtype), v)

    return sweep_query_blocks(block, s_len)


def even_mixer(h, w_in, b_forget, w_out, t5_table):
    bsz, s_len, _ = h.shape
    y = h @ w_in
    fq, fk, fv, ff, dq, dk, dv, iq, ik, iw = split_cols(y, EVEN_SPLITS)
    hd = lambda a, n, d: a.reshape(bsz, s_len, n, d)
    log_f = jax.nn.log_sigmoid(ff.astype(F32) + b_forget.astype(F32))
    log_cum = jnp.transpose(jnp.cumsum(log_f, axis=1), (0, 2, 1))
    fox_out = fox_attention(hd(fq, FOX_HEADS, HEAD_DIM), hd(fk, FOX_HEADS, HEAD_DIM),
                            hd(fv, FOX_HEADS, HEAD_DIM), log_cum)
    dsa_out = dsa_attention(hd(dq, DSA_HEADS, HEAD_DIM), hd(dk, DSA_HEADS, HEAD_DIM),
                            hd(dv, DSA_HEADS, HEAD_DIM), hd(iq, IDX_HEADS, IDX_DIM),
                            ik, iw, t5_table)
    mixed = jnp.concatenate([fox_out.reshape(bsz, s_len, FOX_W),
                             dsa_out.reshape(bsz, s_len, DSA_W)], axis=-1)
    return mixed @ w_out


def odd_mixer(h, w_in, lq1, lk1, lq2, lk2, subln_g, q_norm_g, w_uq, kv_norm_g, w_ukv,
              w_out, t5_table, lambda_init):
    bsz, s_len, _ = h.shape
    y = h @ w_in
    cq, ck, cv, mcq, mckv, mkr = split_cols(y, ODD_SPLITS)
    lam = (jnp.exp(jnp.sum(lq1.astype(F32) * lk1.astype(F32)))
           - jnp.exp(jnp.sum(lq2.astype(F32) * lk2.astype(F32))) + lambda_init)
    diff_out = diff_attention(cq.reshape(bsz, s_len, 2 * DIFF_HEADS, HEAD_DIM),
                              ck.reshape(bsz, s_len, 2 * DIFF_HEADS, HEAD_DIM),
                              cv.reshape(bsz, s_len, DIFF_HEADS, DIFF_VDIM), lam, t5_table)
    diff_out = rms_norm(diff_out, subln_g) * (1.0 - lambda_init)
    q = (rms_norm(mcq, q_norm_g) @ w_uq).reshape(bsz, s_len, MLA_HEADS, MLA_NOPE + MLA_ROPE)
    q_nope, q_rope = q[..., :MLA_NOPE], q[..., MLA_NOPE:]
    kv = (rms_norm(mckv, kv_norm_g) @ w_ukv).reshape(bsz, s_len, MLA_HEADS, MLA_NOPE + MLA_VDIM)
    k_nope, v = kv[..., :MLA_NOPE], kv[..., MLA_NOPE:]
    cos, sin = rope_tables(s_len)
    q_rope = apply_rope(q_rope, cos[:, None, :], sin[:, None, :])
    k_rope = apply_rope(mkr, cos, sin)
    mla_out = mla_attention(q_nope, q_rope, k_nope, k_rope, v)
    mixed = jnp.concatenate([diff_out.reshape(bsz, s_len, DIFF_V_W),
                             mla_out.reshape(bsz, s_len, MLA_OUT_W)], axis=-1)
    return mixed @ w_out


def swiglu(h, w_gate, w_up, w_down):
    return (jax.nn.silu(h @ w_gate) * (h @ w_up)) @ w_down


def setup_inputs(seed: int = 0) -> dict:
    key = jax.random.key(seed)
    ks = jax.random.split(key, 24)
    nrm = lambda k, shape, fan_in: jax.random.normal(k, shape, F32) * (fan_in ** -0.5)
    gain = lambda k, shape: 1.0 + 0.02 * jax.random.normal(k, shape, F32)
    return {
        "x": jax.random.normal(ks[0], (BATCH, SEQ, D_MODEL), F32),
        "norm_mix_g": gain(ks[1], (DEPTH, D_MODEL)),
        "norm_ffn_g": gain(ks[2], (DEPTH, D_MODEL)),
        "w_in_even": nrm(ks[3], (N_EVEN, D_MODEL, EVEN_IN), D_MODEL),
        "b_forget": jax.random.uniform(ks[4], (N_EVEN, FOX_HEADS), F32, 1.0, 4.0),
        "w_out_even": nrm(ks[5], (N_EVEN, EVEN_MIX, D_MODEL), EVEN_MIX),
        "w_in_odd": nrm(ks[6], (N_ODD, D_MODEL, ODD_IN), D_MODEL),
        "lambda_q1": 0.1 * jax.random.normal(ks[7], (N_ODD, HEAD_DIM), F32),
        "lambda_k1": 0.1 * jax.random.normal(ks[8], (N_ODD, HEAD_DIM), F32),
        "lambda_q2": 0.1 * jax.random.normal(ks[9], (N_ODD, HEAD_DIM), F32),
        "lambda_k2": 0.1 * jax.random.normal(ks[10], (N_ODD, HEAD_DIM), F32),
        "diff_subln_g": gain(ks[11], (N_ODD, DIFF_VDIM)),
        "mla_q_norm_g": gain(ks[12], (N_ODD, MLA_Q_RANK)),
        "w_mla_uq": nrm(ks[13], (N_ODD, MLA_Q_RANK, MLA_HEADS * (MLA_NOPE + MLA_ROPE)), MLA_Q_RANK),
        "mla_kv_norm_g": gain(ks[14], (N_ODD, MLA_KV_RANK)),
        "w_mla_ukv": nrm(ks[15], (N_ODD, MLA_KV_RANK, MLA_HEADS * (MLA_NOPE + MLA_VDIM)), MLA_KV_RANK),
        "w_out_odd": nrm(ks[16], (N_ODD, ODD_MIX, D_MODEL), ODD_MIX),
        "t5_bias": 0.5 * jax.random.normal(ks[17], (T5_BUCKETS, T5_HEADS), F32),
        "w_ffn_gate": nrm(ks[18], (DEPTH, D_MODEL, FFN_HIDDEN), D_MODEL),
        "w_ffn_up": nrm(ks[19], (DEPTH, D_MODEL, FFN_HIDDEN), D_MODEL),
        "w_ffn_down": nrm(ks[20], (DEPTH, FFN_HIDDEN, D_MODEL), FFN_HIDDEN),
        "final_norm_g": gain(ks[21], (D_MODEL,)),
    }


def reference(x, norm_mix_g, norm_ffn_g, w_in_even, b_forget, w_out_even, w_in_odd,
              lambda_q1, lambda_k1, lambda_q2, lambda_k2, diff_subln_g, mla_q_norm_g,
              w_mla_uq, mla_kv_norm_g, w_mla_ukv, w_out_odd, t5_bias,
              w_ffn_gate, w_ffn_up, w_ffn_down, final_norm_g):
    for layer in range(DEPTH):
        j = layer // 2
        h = rms_norm(x, norm_mix_g[layer])
        if layer % 2 == 0:
            x = x + even_mixer(h, w_in_even[j], b_forget[j], w_out_even[j], t5_bias)
        else:
            lambda_init = 0.8 - 0.6 * math.exp(-0.3 * layer)
            x = x + odd_mixer(h, w_in_odd[j], lambda_q1[j], lambda_k1[j], lambda_q2[j],
                              lambda_k2[j], diff_subln_g[j], mla_q_norm_g[j], w_mla_uq[j],
                              mla_kv_norm_g[j], w_mla_ukv[j], w_out_odd[j], t5_bias,
                              lambda_init)
        h = rms_norm(x, norm_ffn_g[layer])
        x = x + swiglu(h, w_ffn_gate[layer], w_ffn_up[layer], w_ffn_down[layer])
    return rms_norm(x, final_norm_g)
```

```cpp
#include <hip/hip_runtime.h>
#include <stdint.h>
#include <stdio.h>

typedef unsigned short bf16;
typedef float f32x4 __attribute__((ext_vector_type(4)));
typedef unsigned u32x4 __attribute__((ext_vector_type(4)));
typedef unsigned u32x2 __attribute__((ext_vector_type(2)));
#define LAS __attribute__((address_space(3)))

constexpr int NB = 8, S = 8192, D = 1024, M = NB * S;
constexpr int HD = 64;
constexpr int FFH = 2816;
constexpr int EVEN_IN = 3404, ODD_IN = 1952;
constexpr int Y0P = 3584;
constexpr int Y0_FQ = 0, Y0_FK = 512, Y0_FV = 1024, Y0_DQ = 1536, Y0_DK = 2048, Y0_DV = 2560, Y0_IQ = 3072, Y0_IK = 3328, Y0_FF = 3392, Y0_IW = 3400;
constexpr int Y1P = 2048;
constexpr int Y1_CQ = 0, Y1_CK = 512, Y1_CV = 1024, Y1_MCQ = 1536, Y1_MCKV = 1792, Y1_MKR = 1920;
constexpr int MQP = 768, MKVP = 1024;
constexpr float RMS_EPS = 1e-6f;
constexpr float LAMBDA_INIT = 0.35550906759309494f;
constexpr int NTHR = 512;

constexpr size_t MiB = 1u << 20;
constexpr size_t WS_CTL = 0;
constexpr size_t WS_WIN0 = 2 * MiB;
constexpr size_t WS_WOUT0 = 9 * MiB;
constexpr size_t WS_WGU0 = 11 * MiB;
constexpr size_t WS_WDN0 = 22 * MiB;
constexpr size_t WS_WIN1 = 28 * MiB;
constexpr size_t WS_WUQ = 32 * MiB;
constexpr size_t WS_WUKV = 33 * MiB;
constexpr size_t WS_WOUT1 = 34 * MiB;
constexpr size_t WS_WGU1 = 36 * MiB;
constexpr size_t WS_WDN1 = 47 * MiB;
constexpr size_t WS_ROPE = 56 * MiB;
constexpr size_t WS_TAB = 57 * MiB;
constexpr size_t WS_AUX = 58 * MiB;
constexpr size_t WS_LC = 62 * MiB;
constexpr size_t WS_SSQ = 64 * MiB;
constexpr size_t WS_KR = 68 * MiB;
constexpr size_t WS_XB = 72 * MiB;
constexpr size_t WS_MIX = 200 * MiB;
constexpr size_t WS_MASK = 328 * MiB;
constexpr size_t WS_BIG = 392 * MiB;
constexpr size_t WS_Y1 = WS_BIG;
constexpr size_t WS_MQ = WS_BIG + 256 * MiB;
constexpr size_t WS_MKV = WS_BIG + 352 * MiB;
constexpr size_t WS_END = WS_BIG + 480 * MiB;

#define WAVE_LDS_SYNC() asm volatile("s_waitcnt vmcnt(0) lgkmcnt(0)" ::: "memory")
__device__ __forceinline__ float bf2f(bf16 v) { return __uint_as_float(((unsigned)v) << 16); }
__device__ __forceinline__ bf16 f2bf(float f) { unsigned u = __float_as_uint(f); return (bf16)((u + 0x7fffu + ((u >> 16) & 1u)) >> 16); }
__device__ __forceinline__ unsigned pk2(float lo, float hi) { return (unsigned)f2bf(lo) | ((unsigned)f2bf(hi) << 16); }
__device__ __forceinline__ float wave_sum(float v) {
#pragma unroll
    for (int o = 1; o < 64; o <<= 1) v += __shfl_xor(v, o);
    return v;
}
__device__ __forceinline__ int wave_sum_i(int v) {
#pragma unroll
    for (int o = 1; o < 64; o <<= 1) v += __shfl_xor(v, o);
    return v;
}
__device__ __forceinline__ float wave_max(float v) {
#pragma unroll
    for (int o = 1; o < 64; o <<= 1) v = fmaxf(v, __shfl_xor(v, o));
    return v;
}
__device__ __forceinline__ float row_scale(const float* ssq, int row) {
    const f32x4* p = (const f32x4*)(ssq + (size_t)row * 16);
    f32x4 a = p[0], b = p[1], c = p[2], d = p[3];
    float s = ((a.x + a.y) + (a.z + a.w)) + ((b.x + b.y) + (b.z + b.w)) + ((c.x + c.y) + (c.z + c.w)) + ((d.x + d.y) + (d.z + d.w));
    return 1.0f / sqrtf(s * (1.0f / D) + RMS_EPS);
}
__device__ __forceinline__ int t5_bucket_dev(int dist) {
    if (dist < 16) return dist;
    float d = (float)dist;
    int lb = 16 + (int)(logf(d / 16.0f) / 2.0794415416798357f * 16.0f);
    return lb < 31 ? lb : 31;
}

struct Args {
    const float* in[22];
    float* out;
    unsigned char* ws;
    int ph_lo, ph_hi;
};

struct ColMap {
    int nseg; int d0[10], s0[10], len[10];
    __device__ __forceinline__ int src(int n) const {
        int r = -1;
#pragma unroll
        for (int i = 0; i < 10; ++i) if (i < nseg && n >= d0[i] && n < d0[i] + len[i]) r = s0[i] + (n - d0[i]);
        return r;
    }
};
__device__ __forceinline__ void conv_weight(const float* W, int K, int Nsrc, bf16* Bt, int Ndst, const float* gain, const ColMap& cm,
                                            LAS float* scr, int gw, int ngw, int lane) {
    const int nblk = Ndst / 32, kblk = K / 64;
    for (int it = gw; it < nblk * kblk; it += ngw) {
        const int kb = it / nblk, nb = it % nblk, k0 = kb * 64, n0 = nb * 32;
        const int sc = cm.src(n0 + (lane & 31));
#pragma unroll 8
        for (int i = 0; i < 32; ++i) {
            const int kk = 2 * i + (lane >> 5);
            float v = 0.f;
            if (sc >= 0) v = W[(size_t)(k0 + kk) * Nsrc + sc] * (gain ? gain[k0 + kk] : 1.0f);
            scr[kk * 33 + (lane & 31)] = v;
        }
        WAVE_LDS_SYNC();
        const int c = lane & 7;
#pragma unroll
        for (int j = 0; j < 4; ++j) {
            const int n = (lane >> 3) + 8 * j;
            const LAS float* s = scr + (8 * c) * 33 + n;
            u32x4 o; o.x = pk2(s[0 * 33], s[1 * 33]); o.y = pk2(s[2 * 33], s[3 * 33]); o.z = pk2(s[4 * 33], s[5 * 33]); o.w = pk2(s[6 * 33], s[7 * 33]);
            *(u32x4*)(Bt + (size_t)(n0 + n) * K + k0 + 8 * c) = o;
        }
        WAVE_LDS_SYNC();
    }
}

template <bool GU, class Epi>
__device__ __forceinline__ void naive_gemm(LAS float* sm, const bf16* A, const bf16* Bt, int Mr, int N, int K, const Epi& epi) {
    LAS float* As = sm;
    LAS float* Bs = sm + 32 * 132;
    const int tid = threadIdx.x, ty = tid >> 4, tx = tid & 15;
    const int ntn = N / 128, ntm = Mr / 128;
    const int lrow = tid >> 2, lk = (tid & 3) * 8;
    for (int tile = blockIdx.x; tile < ntn * ntm; tile += gridDim.x) {
        const int tm = tile / ntn, tn = tile % ntn;
        const bf16* Ap = A + (size_t)(tm * 128 + lrow) * K + lk;
        int brow;
        if (GU) { const int hc = tn * 64 + (lrow & 63); brow = 256 * (hc >> 7) + (hc & 127) + ((lrow >> 6) ? 128 : 0); }
        else brow = tn * 128 + lrow;
        const bf16* Bp = Bt + (size_t)brow * K + lk;
        float acc[4][8];
#pragma unroll
        for (int i = 0; i < 4; ++i)
#pragma unroll
            for (int j = 0; j < 8; ++j) acc[i][j] = 0.f;
        for (int k0 = 0; k0 < K; k0 += 32) {
            const u32x4 av = *(const u32x4*)(Ap + k0);
            const u32x4 bv = *(const u32x4*)(Bp + k0);
            __syncthreads();
#pragma unroll
            for (int j = 0; j < 4; ++j) {
                As[(lk + 2 * j) * 132 + lrow] = __uint_as_float(av[j] << 16);
                As[(lk + 2 * j + 1) * 132 + lrow] = __uint_as_float(av[j] & 0xffff0000u);
                Bs[(lk + 2 * j) * 132 + lrow] = __uint_as_float(bv[j] << 16);
                Bs[(lk + 2 * j + 1) * 132 + lrow] = __uint_as_float(bv[j] & 0xffff0000u);
            }
            __syncthreads();
#pragma unroll 8
            for (int kk = 0; kk < 32; ++kk) {
                const f32x4 a = *(const LAS f32x4*)(As + kk * 132 + 4 * ty);
                const f32x4 b0 = *(const LAS f32x4*)(Bs + kk * 132 + 4 * tx);
                const f32x4 b1 = *(const LAS f32x4*)(Bs + kk * 132 + 64 + 4 * tx);
#pragma unroll
                for (int i = 0; i < 4; ++i) {
#pragma unroll
                    for (int j = 0; j < 4; ++j) { acc[i][j] = fmaf(a[i], b0[j], acc[i][j]); acc[i][4 + j] = fmaf(a[i], b1[j], acc[i][4 + j]); }
                }
            }
        }
#pragma unroll
        for (int i = 0; i < 4; ++i) {
            const int row = tm * 128 + 4 * ty + i;
            const f32x4 v0 = {acc[i][0], acc[i][1], acc[i][2], acc[i][3]};
            const f32x4 v1 = {acc[i][4], acc[i][5], acc[i][6], acc[i][7]};
            if constexpr (GU) epi.store_gu(row, tn * 64 + 4 * tx, v0, v1);
            else { epi.store(row, tn * 128 + 4 * tx, v0); epi.store(row, tn * 128 + 64 + 4 * tx, v1); }
        }
    }
}

struct EpiScaleBf16 {
    bf16* O; int ldo; const float* ssq; float* aux; int aux_c0, aux_n;
    __device__ __forceinline__ void store(int row, int col, f32x4 v) const {
        const float rs = row_scale(ssq, row);
        v = v * rs;
        u32x2 w; w.x = pk2(v.x, v.y); w.y = pk2(v.z, v.w);
        *(u32x2*)(O + (size_t)row * ldo + col) = w;
        if (aux && col >= aux_c0 && col < aux_c0 + aux_n) *(f32x4*)(aux + (size_t)row * 16 + (col - aux_c0)) = v;
    }
};
struct EpiResid {
    const float* resid; float* xout; bf16* xb;
    __device__ __forceinline__ void store(int row, int col, f32x4 v) const {
        const size_t off = (size_t)row * D + col;
        const f32x4 r = *(const f32x4*)(resid + off);
        v = v + r;
        *(f32x4*)(xout + off) = v;
        u32x2 w; w.x = pk2(v.x, v.y); w.y = pk2(v.z, v.w);
        *(u32x2*)(xb + off) = w;
    }
};
__device__ __forceinline__ float silu_f(float x) { return x / (1.0f + __expf(-x)); }
struct EpiGU {
    bf16* Hd; const float* ssq;
    __device__ __forceinline__ void store_gu(int row, int hc, f32x4 g, f32x4 u) const {
        const float rs = row_scale(ssq, row);
        g = g * rs; u = u * rs;
        f32x4 h; h.x = silu_f(g.x) * u.x; h.y = silu_f(g.y) * u.y; h.z = silu_f(g.z) * u.z; h.w = silu_f(g.w) * u.w;
        u32x2 w; w.x = pk2(h.x, h.y); w.y = pk2(h.z, h.w);
        *(u32x2*)(Hd + (size_t)row * FFH + hc) = w;
    }
};

__device__ __forceinline__ int block_count(int local, LAS int* red, int wave, int lane) {
    const int w = wave_sum_i(local);
    if (lane == 0) red[wave] = w;
    __syncthreads();
    int t = 0;
#pragma unroll
    for (int i = 0; i < 8; ++i) t += red[i];
    __syncthreads();
    return t;
}
__device__ __forceinline__ unsigned okey(float f) { const unsigned u = __float_as_uint(f); return (u & 0x80000000u) ? ~u : (u | 0x80000000u); }

template <int PH>
__device__ __forceinline__ void mk_body(const Args& a) {
    extern __shared__ __attribute__((aligned(16))) unsigned char lds_raw[];
    LAS unsigned char* lds = (LAS unsigned char*)lds_raw;
    const int tid = threadIdx.x, lane = tid & 63, wave = __builtin_amdgcn_readfirstlane(tid >> 6);
    const int G = gridDim.x, bid = blockIdx.x;
    const int gw = bid * 8 + wave, ngw = G * 8;
    unsigned char* ws = a.ws;
    const float* x_in = a.in[0];
    float* xres = a.out;
    bf16* Wt_in0 = (bf16*)(ws + WS_WIN0); bf16* Wt_out0 = (bf16*)(ws + WS_WOUT0); bf16* Wt_gu0 = (bf16*)(ws + WS_WGU0); bf16* Wt_dn0 = (bf16*)(ws + WS_WDN0);
    bf16* Wt_in1 = (bf16*)(ws + WS_WIN1); bf16* Wt_uq = (bf16*)(ws + WS_WUQ); bf16* Wt_ukv = (bf16*)(ws + WS_WUKV); bf16* Wt_out1 = (bf16*)(ws + WS_WOUT1);
    bf16* Wt_gu1 = (bf16*)(ws + WS_WGU1); bf16* Wt_dn1 = (bf16*)(ws + WS_WDN1);
    float* rope_cos = (float*)(ws + WS_ROPE); float* rope_sin = rope_cos + S * 16;
    int* bucket_tab = (int*)(ws + WS_TAB);
    float* aux = (float*)(ws + WS_AUX); float* lc = (float*)(ws + WS_LC); float* ssq = (float*)(ws + WS_SSQ);
    bf16* krope = (bf16*)(ws + WS_KR); bf16* xb = (bf16*)(ws + WS_XB); bf16* mixed = (bf16*)(ws + WS_MIX);
    bf16* y0 = (bf16*)(ws + WS_BIG); bf16* hidden = (bf16*)(ws + WS_BIG); bf16* y1 = (bf16*)(ws + WS_Y1); bf16* mq = (bf16*)(ws + WS_MQ); bf16* mkv = (bf16*)(ws + WS_MKV);
    const float* t5 = a.in[17];
    const int lo = a.ph_lo, hi = a.ph_hi;
#define IN(k) (PH < 0 ? (lo <= (k) && (k) < hi) : (PH == (k)))

    if (IN(0)) {
        LAS float* scr = (LAS float*)lds + wave * (64 * 33);
        {
            ColMap cm; cm.nseg = 10;
            const int d0[10] = {Y0_FQ, Y0_FK, Y0_FV, Y0_DQ, Y0_DK, Y0_DV, Y0_IQ, Y0_IK, Y0_FF, Y0_IW};
            const int s0[10] = {0, 512, 1024, 1544, 2056, 2568, 3080, 3336, 1536, 3400};
            const int ln[10] = {512, 512, 512, 512, 512, 512, 256, 64, 8, 4};
#pragma unroll
            for (int i = 0; i < 10; ++i) { cm.d0[i] = d0[i]; cm.s0[i] = s0[i]; cm.len[i] = ln[i]; }
            conv_weight(a.in[3], D, EVEN_IN, Wt_in0, Y0P, a.in[1], cm, scr, gw, ngw, lane);
        }
        {
            ColMap cm; cm.nseg = 1; cm.d0[0] = 0; cm.s0[0] = 0;
#pragma unroll
            for (int i = 1; i < 10; ++i) { cm.d0[i] = 0; cm.s0[i] = 0; cm.len[i] = 0; }
            cm.len[0] = D;
            conv_weight(a.in[5], D, D, Wt_out0, D, nullptr, cm, scr, gw, ngw, lane);
            conv_weight(a.in[16], D, D, Wt_out1, D, nullptr, cm, scr, gw, ngw, lane);
            conv_weight(a.in[20], FFH, D, Wt_dn0, D, nullptr, cm, scr, gw, ngw, lane);
            conv_weight(a.in[20] + (size_t)FFH * D, FFH, D, Wt_dn1, D, nullptr, cm, scr, gw, ngw, lane);
            cm.len[0] = ODD_IN;
            conv_weight(a.in[6], D, ODD_IN, Wt_in1, Y1P, a.in[1] + D, cm, scr, gw, ngw, lane);
            cm.len[0] = 768;
            conv_weight(a.in[13], 256, 768, Wt_uq, 768, a.in[12], cm, scr, gw, ngw, lane);
            cm.len[0] = 1024;
            conv_weight(a.in[15], 128, 1024, Wt_ukv, 1024, a.in[14], cm, scr, gw, ngw, lane);
        }
        for (int j = 0; j < 22; ++j) {
            ColMap cm; cm.nseg = 1; cm.d0[0] = 256 * j; cm.s0[0] = 128 * j; cm.len[0] = 128;
#pragma unroll
            for (int i = 1; i < 10; ++i) { cm.d0[i] = 0; cm.s0[i] = 0; cm.len[i] = 0; }
            ColMap c2 = cm; c2.d0[0] = 0;
            conv_weight(a.in[18], D, FFH, Wt_gu0 + (size_t)(256 * j) * D, 128, a.in[2], c2, scr, gw, ngw, lane);
            conv_weight(a.in[19], D, FFH, Wt_gu0 + (size_t)(256 * j + 128) * D, 128, a.in[2], c2, scr, gw, ngw, lane);
            conv_weight(a.in[18] + (size_t)D * FFH, D, FFH, Wt_gu1 + (size_t)(256 * j) * D, 128, a.in[2] + D, c2, scr, gw, ngw, lane);
            conv_weight(a.in[19] + (size_t)D * FFH, D, FFH, Wt_gu1 + (size_t)(256 * j + 128) * D, 128, a.in[2] + D, c2, scr, gw, ngw, lane);
        }
        for (int m = gw; m < M; m += ngw) {
            const f32x4* xr = (const f32x4*)(x_in + (size_t)m * D) + lane;
            unsigned long long* o8 = (unsigned long long*)(xb + (size_t)m * D) + lane;
            float s = 0.f;
#pragma unroll
            for (int j = 0; j < 4; ++j) {
                const f32x4 v = xr[64 * j];
                s += (v.x * v.x + v.y * v.y) + (v.z * v.z + v.w * v.w);
                o8[64 * j] = (unsigned long long)pk2(v.x, v.y) | ((unsigned long long)pk2(v.z, v.w) << 32);
            }
            s = wave_sum(s);
            if (lane < 16) ssq[(size_t)m * 16 + lane] = (lane == 0) ? s : 0.f;
        }
        for (int i = bid * NTHR + tid; i < S * 16; i += G * NTHR) {
            const int pos = i >> 4, j = i & 15;
            const float inv = powf(10000.0f, -(float)(2 * j) / 32.0f);
            const float ang = (float)pos * inv;
            rope_cos[i] = cosf(ang); rope_sin[i] = sinf(ang);
        }
        if (bid == 0 && tid < 128) bucket_tab[tid] = t5_bucket_dev(tid);
    }

    if (IN(1)) {
        EpiScaleBf16 E{y0, Y0P, ssq, aux, Y0_FF, 12};
        naive_gemm<false>((LAS float*)lds, xb, Wt_in0, M, Y0P, D, E);
    }

    if (IN(2)) {
        for (int seq = gw; seq < NB * 8; seq += ngw) {
            const int b = seq >> 3, h = seq & 7;
            const float bf = a.in[4][h];
            const int s0 = lane * 128;
            float tot = 0.f;
            for (int i = 0; i < 128; ++i) {
                const float z = aux[(size_t)(b * S + s0 + i) * 16 + h] + bf;
                tot += fminf(z, 0.f) - log1pf(expf(-fabsf(z)));
            }
            float incl = tot;
#pragma unroll
            for (int o = 1; o < 64; o <<= 1) { const float v = __shfl_up(incl, o); if (lane >= o) incl += v; }
            float run = incl - tot;
            for (int i = 0; i < 128; ++i) {
                const float z = aux[(size_t)(b * S + s0 + i) * 16 + h] + bf;
                run += fminf(z, 0.f) - log1pf(expf(-fabsf(z)));
                lc[(size_t)(b * S + s0 + i) * 8 + h] = run;
            }
        }
    }

    if (IN(3)) {
        for (int u = bid; u < NB * 8 * 16; u += G) {
            const int chunk = 15 - (u >> 6), bh = u & 63, b = bh >> 3, h = bh & 7;
            const int t = chunk * 512 + tid;
            const size_t row = (size_t)b * S + t;
            float q[64], o[64];
            {
                const u32x4* qp = (const u32x4*)(y0 + row * Y0P + Y0_FQ + h * 64);
#pragma unroll
                for (int i = 0; i < 8; ++i) { const u32x4 v = qp[i];
#pragma unroll
                    for (int j = 0; j < 4; ++j) { q[i * 8 + 2 * j] = __uint_as_float(v[j] << 16) * 0.125f; q[i * 8 + 2 * j + 1] = __uint_as_float(v[j] & 0xffff0000u) * 0.125f; } }
            }
#pragma unroll
            for (int d = 0; d < 64; ++d) o[d] = 0.f;
            const float ct = lc[row * 8 + h];
            float mx = -INFINITY, l = 0.f;
            const int smax = chunk * 512 + wave * 64 + 63;
            const bf16* kb = y0 + (size_t)b * S * Y0P + Y0_FK + h * 64;
            const bf16* vb = y0 + (size_t)b * S * Y0P + Y0_FV + h * 64;
            const float* lcb = lc + (size_t)b * S * 8 + h;
            _Pragma("unroll 1") for (int s = 0; s <= smax; ++s) {
                const u32x4* kp = (const u32x4*)(kb + (size_t)s * Y0P);
                float dot = 0.f;
#pragma unroll
                for (int i = 0; i < 8; ++i) { const u32x4 v = kp[i];
#pragma unroll
                    for (int j = 0; j < 4; ++j) { dot = fmaf(q[i * 8 + 2 * j], __uint_as_float(v[j] << 16), dot); dot = fmaf(q[i * 8 + 2 * j + 1], __uint_as_float(v[j] & 0xffff0000u), dot); } }
                const float logit = dot + (ct - lcb[(size_t)s * 8]);
                if (s <= t) {
                    const float mn = fmaxf(mx, logit);
                    const float al = __expf(mx - mn), p = __expf(logit - mn);
                    mx = mn; l = l * al + p;
                    const u32x4* vp = (const u32x4*)(vb + (size_t)s * Y0P);
#pragma unroll
                    for (int i = 0; i < 8; ++i) { const u32x4 v = vp[i];
#pragma unroll
                        for (int j = 0; j < 4; ++j) { o[i * 8 + 2 * j] = fmaf(o[i * 8 + 2 * j], al, p * __uint_as_float(v[j] << 16)); o[i * 8 + 2 * j + 1] = fmaf(o[i * 8 + 2 * j + 1], al, p * __uint_as_float(v[j] & 0xffff0000u)); } }
                }
            }
            const float il = 1.0f / l;
            u32x4* op = (u32x4*)(mixed + row * D + h * 64);
#pragma unroll
            for (int i = 0; i < 8; ++i) { u32x4 w;
#pragma unroll
                for (int j = 0; j < 4; ++j) w[j] = pk2(o[i * 8 + 2 * j] * il, o[i * 8 + 2 * j + 1] * il);
                op[i] = w; }
        }
    }

    if (IN(4)) {
        LAS float* sc = (LAS float*)lds;
        LAS float* qi = sc + 8192;
        LAS float* lg = qi + 256;
        LAS int* sel = (LAS int*)(lg + 2048);
        LAS int* red = sel + 256;
        LAS int* nselp = red + 8;
        LAS float* wq = (LAS float*)(nselp + 8);
        for (int qn = bid; qn < M; qn += G) {
            const int qrow = M - 1 - qn;
            const int b = qrow / S, t = qrow % S;
            const size_t rowbase = (size_t)b * S;
            if (tid < 256) qi[tid] = bf2f(y0[(size_t)qrow * Y0P + Y0_IQ + tid]);
            if (tid < 4) wq[tid] = aux[(size_t)qrow * 16 + 8 + tid];
            if (tid == 0) nselp[0] = 0;
            __syncthreads();
            const int n = t + 1;
            for (int s = tid; s < n; s += NTHR) {
                const u32x4* kp = (const u32x4*)(y0 + (rowbase + s) * Y0P + Y0_IK);
                float d0 = 0.f, d1 = 0.f, d2 = 0.f, d3 = 0.f;
#pragma unroll
                for (int i = 0; i < 8; ++i) { const u32x4 v = kp[i];
#pragma unroll
                    for (int j = 0; j < 4; ++j) {
                        const float k0 = __uint_as_float(v[j] << 16), k1 = __uint_as_float(v[j] & 0xffff0000u);
                        const int dd = i * 8 + 2 * j;
                        d0 = fmaf(qi[dd], k0, d0); d0 = fmaf(qi[dd + 1], k1, d0);
                        d1 = fmaf(qi[64 + dd], k0, d1); d1 = fmaf(qi[64 + dd + 1], k1, d1);
                        d2 = fmaf(qi[128 + dd], k0, d2); d2 = fmaf(qi[128 + dd + 1], k1, d2);
                        d3 = fmaf(qi[192 + dd], k0, d3); d3 = fmaf(qi[192 + dd + 1], k1, d3);
                    } }
                float sv = fmaxf(d0, 0.f) * wq[0];
                sv = fmaf(fmaxf(d1, 0.f), wq[1], sv); sv = fmaf(fmaxf(d2, 0.f), wq[2], sv); sv = fmaf(fmaxf(d3, 0.f), wq[3], sv);
                sv *= 0.0625f;
                if (sv == 0.f) sv = 0.f;
                sc[s] = sv;
            }
            __syncthreads();
            unsigned tau = 0u; int istar = n;
            if (n > 256) {
                unsigned prefix = 0u;
                for (int bit = 31; bit >= 0; --bit) {
                    const unsigned cand = prefix | (1u << bit);
                    int c = 0;
                    for (int s = tid; s < n; s += NTHR) c += (okey(sc[s]) >= cand) ? 1 : 0;
                    c = block_count(c, red, wave, lane);
                    if (c >= 256) prefix = cand;
                }
                tau = prefix;
                int cg = 0;
                for (int s = tid; s < n; s += NTHR) cg += (okey(sc[s]) > tau) ? 1 : 0;
                cg = block_count(cg, red, wave, lane);
                const int need = 256 - cg;
                int lo_i = 0, hi_i = n - 1;
                while (lo_i < hi_i) {
                    const int mid = (lo_i + hi_i) >> 1;
                    int c = 0;
                    for (int s = tid; s < n; s += NTHR) c += (okey(sc[s]) == tau && s <= mid) ? 1 : 0;
                    c = block_count(c, red, wave, lane);
                    if (c >= need) hi_i = mid; else lo_i = mid + 1;
                }
                istar = lo_i;
            }
            for (int s = tid; s < n; s += NTHR) {
                const unsigned k = okey(sc[s]);
                const bool pick = (n <= 256) || (k > tau) || (k == tau && s <= istar);
                if (pick) { const int pos = atomicAdd((int*)nselp, 1); if (pos < 256) sel[pos] = s; }
            }
            __syncthreads();
            const int ns = nselp[0] < 256 ? nselp[0] : 256;
            for (int idx = tid; idx < ns * 8; idx += NTHR) {
                const int h = idx / ns, j = idx - h * ns;
                const int s = sel[j];
                const u32x4* kp = (const u32x4*)(y0 + (rowbase + s) * Y0P + Y0_DK + h * 64);
                const u32x4* qp = (const u32x4*)(y0 + (size_t)qrow * Y0P + Y0_DQ + h * 64);
                float dot = 0.f;
#pragma unroll
                for (int i = 0; i < 8; ++i) { const u32x4 kv = kp[i], qv = qp[i];
#pragma unroll
                    for (int jj = 0; jj < 4; ++jj) { dot = fmaf(__uint_as_float(qv[jj] << 16), __uint_as_float(kv[jj] << 16), dot); dot = fmaf(__uint_as_float(qv[jj] & 0xffff0000u), __uint_as_float(kv[jj] & 0xffff0000u), dot); } }
                const int dist = t - s;
                const int bk = dist < 128 ? bucket_tab[dist] : 31;
                lg[h * 256 + j] = dot * 0.125f + t5[bk * 8 + h];
            }
            __syncthreads();
            {
                float mxv = -INFINITY;
                for (int j = lane; j < ns; j += 64) mxv = fmaxf(mxv, lg[wave * 256 + j]);
                mxv = wave_max(mxv);
                float sum = 0.f;
                for (int j = lane; j < ns; j += 64) { const float p = __expf(lg[wave * 256 + j] - mxv); lg[wave * 256 + j] = p; sum += p; }
                sum = wave_sum(sum);
                const float inv = 1.0f / sum;
                for (int j = lane; j < ns; j += 64) lg[wave * 256 + j] *= inv;
            }
            __syncthreads();
            {
                float o = 0.f;
                const bf16* vb = y0 + rowbase * Y0P + Y0_DV + wave * 64 + lane;
                for (int j = 0; j < ns; ++j) o = fmaf(lg[wave * 256 + j], bf2f(vb[(size_t)sel[j] * Y0P]), o);
                mixed[(size_t)qrow * D + 512 + wave * 64 + lane] = f2bf(o);
            }
            __syncthreads();
        }
    }

    if (IN(5)) { EpiResid E{x_in, xres, xb}; naive_gemm<false>((LAS float*)lds, mixed, Wt_out0, M, D, D, E); }

    if (IN(6) || IN(9) || IN(15)) {
        for (int m = gw; m < M; m += ngw) {
            const f32x4* xr = (const f32x4*)(xres + (size_t)m * D) + lane;
            float s = 0.f;
#pragma unroll
            for (int j = 0; j < 4; ++j) { const f32x4 v = xr[64 * j]; s += (v.x * v.x + v.y * v.y) + (v.z * v.z + v.w * v.w); }
            s = wave_sum(s);
            if (lane < 16) ssq[(size_t)m * 16 + lane] = (lane == 0) ? s : 0.f;
        }
    }

    if (IN(7)) { EpiGU E{hidden, ssq}; naive_gemm<true>((LAS float*)lds, xb, Wt_gu0, M, FFH * 2, D, E); }
    if (IN(8)) { EpiResid E{xres, xres, xb}; naive_gemm<false>((LAS float*)lds, hidden, Wt_dn0, M, D, FFH, E); }

    if (IN(10)) { EpiScaleBf16 E{y1, Y1P, ssq, nullptr, 0, 0}; naive_gemm<false>((LAS float*)lds, xb, Wt_in1, M, Y1P, D, E); }

    if (IN(11)) {
        LAS float* cq = (LAS float*)lds + wave * 1280;
        LAS float* qs = cq + 384;
        for (int m = gw; m < M; m += ngw) {
            const int t = m % S;
            const bf16* yr = y1 + (size_t)m * Y1P;
            float s1 = 0.f, s2 = 0.f;
            float v4[4];
#pragma unroll
            for (int j = 0; j < 4; ++j) { v4[j] = bf2f(yr[Y1_MCQ + lane + 64 * j]); s1 += v4[j] * v4[j]; }
            float w2[2];
#pragma unroll
            for (int j = 0; j < 2; ++j) { w2[j] = bf2f(yr[Y1_MCKV + lane + 64 * j]); s2 += w2[j] * w2[j]; }
            s1 = wave_sum(s1); s2 = wave_sum(s2);
            const float r1 = 1.0f / sqrtf(s1 * (1.0f / 256.0f) + RMS_EPS), r2 = 1.0f / sqrtf(s2 * (1.0f / 128.0f) + RMS_EPS);
#pragma unroll
            for (int j = 0; j < 4; ++j) cq[lane + 64 * j] = v4[j];
#pragma unroll
            for (int j = 0; j < 2; ++j) cq[256 + lane + 64 * j] = w2[j];
            WAVE_LDS_SYNC();
#pragma unroll 1
            for (int j = 0; j < 12; ++j) {
                const int c = lane + 64 * j;
                const bf16* wr = Wt_uq + (size_t)c * 256;
                float acc = 0.f;
#pragma unroll 2
                for (int k = 0; k < 256; k += 8) { const u32x4 w = *(const u32x4*)(wr + k);
#pragma unroll
                    for (int jj = 0; jj < 4; ++jj) { acc = fmaf(cq[k + 2 * jj], __uint_as_float(w[jj] << 16), acc); acc = fmaf(cq[k + 2 * jj + 1], __uint_as_float(w[jj] & 0xffff0000u), acc); } }
                qs[c] = acc * r1;
            }
            WAVE_LDS_SYNC();
#pragma unroll 1
            for (int j = 0; j < 12; ++j) {
                const int c = lane + 64 * j;
                const int hh = c / 96, cc = c - hh * 96;
                float outv = qs[c];
                if (cc >= 64) {
                    const int i = cc - 64, fi = i & 15;
                    const float pv = qs[(i < 16) ? c + 16 : c - 16];
                    const float cs = rope_cos[t * 16 + fi], sn = rope_sin[t * 16 + fi];
                    outv = (i < 16) ? (outv * cs - pv * sn) : (outv * cs + pv * sn);
                }
                mq[(size_t)m * MQP + c] = f2bf(outv);
            }
#pragma unroll 1
            for (int j = 0; j < 16; ++j) {
                const int c = lane + 64 * j;
                const bf16* wr = Wt_ukv + (size_t)c * 128;
                float acc = 0.f;
#pragma unroll 2
                for (int k = 0; k < 128; k += 8) { const u32x4 w = *(const u32x4*)(wr + k);
#pragma unroll
                    for (int jj = 0; jj < 4; ++jj) { acc = fmaf(cq[256 + k + 2 * jj], __uint_as_float(w[jj] << 16), acc); acc = fmaf(cq[256 + k + 2 * jj + 1], __uint_as_float(w[jj] & 0xffff0000u), acc); } }
                mkv[(size_t)m * MKVP + c] = f2bf(acc * r2);
            }
            if (lane < 32) {
                const int i = lane, fi = i & 15;
                const float xv = bf2f(yr[Y1_MKR + i]);
                const float pv = bf2f(yr[Y1_MKR + ((i < 16) ? i + 16 : i - 16)]);
                const float cs = rope_cos[t * 16 + fi], sn = rope_sin[t * 16 + fi];
                krope[(size_t)m * 32 + i] = f2bf((i < 16) ? (xv * cs - pv * sn) : (xv * cs + pv * sn));
            }
            WAVE_LDS_SYNC();
        }
    }

    if (IN(12)) {
        float lam;
        {
            float s1 = 0.f, s2 = 0.f;
            for (int i = 0; i < 64; ++i) { s1 += a.in[7][i] * a.in[8][i]; s2 += a.in[9][i] * a.in[10][i]; }
            lam = expf(s1) - expf(s2) + LAMBDA_INIT;
        }
        for (int u = bid; u < NB * 4 * 32; u += G) {
            const int chunk = 31 - (u >> 5), bh = u & 31, b = bh >> 2, h = bh & 3;
            const int t = chunk * 256 + (tid >> 1), half = tid & 1;
            const size_t row = (size_t)b * S + t;
            float oa[64];
            const int smax = chunk * 256 + wave * 32 + 31;
            for (int mp = 0; mp < 2; ++mp) {
                const int mh = 2 * h + mp;
                float q[64], o[64];
                {
                    const u32x4* qp = (const u32x4*)(y1 + row * Y1P + Y1_CQ + mh * 64);
#pragma unroll
                    for (int i = 0; i < 8; ++i) { const u32x4 v = qp[i];
#pragma unroll
                        for (int j = 0; j < 4; ++j) { q[i * 8 + 2 * j] = __uint_as_float(v[j] << 16) * 0.125f; q[i * 8 + 2 * j + 1] = __uint_as_float(v[j] & 0xffff0000u) * 0.125f; } }
                }
#pragma unroll
                for (int d = 0; d < 64; ++d) o[d] = 0.f;
                float mx = -INFINITY, l = 0.f;
                const bf16* kb = y1 + (size_t)b * S * Y1P + Y1_CK + mh * 64;
                const bf16* vb = y1 + (size_t)b * S * Y1P + Y1_CV + h * 128 + half * 64;
                _Pragma("unroll 1") for (int s = 0; s <= smax; ++s) {
                    const u32x4* kp = (const u32x4*)(kb + (size_t)s * Y1P);
                    float dot = 0.f;
#pragma unroll
                    for (int i = 0; i < 8; ++i) { const u32x4 v = kp[i];
#pragma unroll
                        for (int j = 0; j < 4; ++j) { dot = fmaf(q[i * 8 + 2 * j], __uint_as_float(v[j] << 16), dot); dot = fmaf(q[i * 8 + 2 * j + 1], __uint_as_float(v[j] & 0xffff0000u), dot); } }
                    if (s <= t) {
                        const int dist = t - s;
                        const int bk = dist < 128 ? bucket_tab[dist] : 31;
                        const float logit = dot + t5[bk * 8 + mh];
                        const float mn = fmaxf(mx, logit);
                        const float al = __expf(mx - mn), p = __expf(logit - mn);
                        mx = mn; l = l * al + p;
                        const u32x4* vp = (const u32x4*)(vb + (size_t)s * Y1P);
#pragma unroll
                        for (int i = 0; i < 8; ++i) { const u32x4 v = vp[i];
#pragma unroll
                            for (int j = 0; j < 4; ++j) { o[i * 8 + 2 * j] = fmaf(o[i * 8 + 2 * j], al, p * __uint_as_float(v[j] << 16)); o[i * 8 + 2 * j + 1] = fmaf(o[i * 8 + 2 * j + 1], al, p * __uint_as_float(v[j] & 0xffff0000u)); } }
                    }
                }
                const float il = 1.0f / l;
                if (mp == 0) {
#pragma unroll
                    for (int d = 0; d < 64; ++d) oa[d] = o[d] * il;
                } else {
#pragma unroll
                    for (int d = 0; d < 64; ++d) oa[d] = oa[d] - lam * (o[d] * il);
                }
            }
            float ss = 0.f;
#pragma unroll
            for (int d = 0; d < 64; ++d) ss += oa[d] * oa[d];
            ss += __shfl_xor(ss, 1);
            const float rn = (1.0f / sqrtf(ss * (1.0f / 128.0f) + RMS_EPS)) * (1.0f - LAMBDA_INIT);
            const float* gg = a.in[11] + half * 64;
            u32x4* op = (u32x4*)(mixed + row * D + h * 128 + half * 64);
#pragma unroll
            for (int i = 0; i < 8; ++i) { u32x4 w;
#pragma unroll
                for (int j = 0; j < 4; ++j) w[j] = pk2(oa[i * 8 + 2 * j] * rn * gg[i * 8 + 2 * j], oa[i * 8 + 2 * j + 1] * rn * gg[i * 8 + 2 * j + 1]);
                op[i] = w; }
        }
    }

    if (IN(13)) {
        const float sc96 = 0.10206207261596575f;
        for (int u = bid; u < NB * 8 * 32; u += G) {
            const int chunk = 31 - (u >> 6), bh = u & 63, b = bh >> 3, h = bh & 7;
            const int t = chunk * 256 + (tid >> 1), half = tid & 1;
            const size_t row = (size_t)b * S + t;
            unsigned qk[48]; float o[32];
            {
                const u32x4* qp = (const u32x4*)(mq + row * MQP + h * 96);
#pragma unroll
                for (int i = 0; i < 12; ++i) { const u32x4 v = qp[i];
#pragma unroll
                    for (int j = 0; j < 4; ++j) qk[i * 4 + j] = v[j]; }
            }
#pragma unroll
            for (int d = 0; d < 32; ++d) o[d] = 0.f;
            float mx = -INFINITY, l = 0.f;
            const int smax = chunk * 256 + wave * 32 + 31;
            const bf16* kb = mkv + (size_t)b * S * MKVP + h * 128;
            const bf16* rb = krope + (size_t)b * S * 32;
            _Pragma("unroll 1") for (int s = 0; s <= smax; ++s) {
                const u32x4* kp = (const u32x4*)(kb + (size_t)s * MKVP);
                const u32x4* rp = (const u32x4*)(rb + (size_t)s * 32);
                float dot = 0.f;
#pragma unroll
                for (int i = 0; i < 8; ++i) { const u32x4 v = kp[i];
#pragma unroll
                    for (int j = 0; j < 4; ++j) { dot = fmaf(__uint_as_float(qk[i * 4 + j] << 16), __uint_as_float(v[j] << 16), dot); dot = fmaf(__uint_as_float(qk[i * 4 + j] & 0xffff0000u), __uint_as_float(v[j] & 0xffff0000u), dot); } }
#pragma unroll
                for (int i = 0; i < 4; ++i) { const u32x4 v = rp[i];
#pragma unroll
                    for (int j = 0; j < 4; ++j) { dot = fmaf(__uint_as_float(qk[32 + i * 4 + j] << 16), __uint_as_float(v[j] << 16), dot); dot = fmaf(__uint_as_float(qk[32 + i * 4 + j] & 0xffff0000u), __uint_as_float(v[j] & 0xffff0000u), dot); } }
                if (s <= t) {
                    const float logit = dot * sc96;
                    const float mn = fmaxf(mx, logit);
                    const float al = __expf(mx - mn), p = __expf(logit - mn);
                    mx = mn; l = l * al + p;
                    const u32x4* vp = (const u32x4*)(kb + (size_t)s * MKVP + 64 + half * 32);
#pragma unroll
                    for (int i = 0; i < 4; ++i) { const u32x4 v = vp[i];
#pragma unroll
                        for (int j = 0; j < 4; ++j) { o[i * 8 + 2 * j] = fmaf(o[i * 8 + 2 * j], al, p * __uint_as_float(v[j] << 16)); o[i * 8 + 2 * j + 1] = fmaf(o[i * 8 + 2 * j + 1], al, p * __uint_as_float(v[j] & 0xffff0000u)); } }
                }
            }
            const float il = 1.0f / l;
            u32x4* op = (u32x4*)(mixed + row * D + 512 + h * 64 + half * 32);
#pragma unroll
            for (int i = 0; i < 4; ++i) { u32x4 w;
#pragma unroll
                for (int j = 0; j < 4; ++j) w[j] = pk2(o[i * 8 + 2 * j] * il, o[i * 8 + 2 * j + 1] * il);
                op[i] = w; }
        }
    }

    if (IN(14)) { EpiResid E{xres, xres, xb}; naive_gemm<false>((LAS float*)lds, mixed, Wt_out1, M, D, D, E); }
    if (IN(16)) { EpiGU E{hidden, ssq}; naive_gemm<true>((LAS float*)lds, xb, Wt_gu1, M, FFH * 2, D, E); }
    if (IN(17)) { EpiResid E{xres, xres, xb}; naive_gemm<false>((LAS float*)lds, hidden, Wt_dn1, M, D, FFH, E); }

    if (IN(18)) {
        const float* fg = a.in[21];
        for (int m = gw; m < M; m += ngw) {
            f32x4* xr = (f32x4*)(xres + (size_t)m * D) + lane;
            f32x4 v[4]; float s = 0.f;
#pragma unroll
            for (int j = 0; j < 4; ++j) { v[j] = xr[64 * j]; s += (v[j].x * v[j].x + v[j].y * v[j].y) + (v[j].z * v[j].z + v[j].w * v[j].w); }
            s = wave_sum(s);
            const float rs = 1.0f / sqrtf(s * (1.0f / D) + RMS_EPS);
#pragma unroll
            for (int j = 0; j < 4; ++j) { const f32x4 g = *((const f32x4*)fg + lane + 64 * j); xr[64 * j] = v[j] * rs * g; }
        }
    }
#undef IN
}
template <int PH>
__global__ void __launch_bounds__(NTHR, 2) mk_phase(Args a) { mk_body<PH>(a); }

constexpr int LDS_BYTES = 80 * 1024;
constexpr int N_PHASES = 19;

extern "C" void kernel_launch(void* const* d_in, const int* in_sizes, int n_in, void* d_out, int out_size, void* d_ws, size_t ws_size, hipStream_t stream) {
    static int grid = 0;
    if (grid == 0) {
        if (n_in != 22 || out_size != M * D || ws_size < WS_END) { fprintf(stderr, "kernel_launch: unexpected sizes n_in %d out %d ws %zu\n", n_in, out_size, ws_size); grid = -1; return; }
        int dev = 0, cus = 0;
        if (hipGetDevice(&dev) != hipSuccess || hipDeviceGetAttribute(&cus, hipDeviceAttributeMultiprocessorCount, dev) != hipSuccess) { grid = -1; return; }
        grid = cus * 2;
    }
    if (grid < 0) return;
    (void)hipMemsetAsync((char*)d_ws + WS_CTL, 0, 1 * MiB, stream);
    Args a{};
    for (int i = 0; i < 22; ++i) a.in[i] = (const float*)d_in[i];
    a.out = (float*)d_out; a.ws = (unsigned char*)d_ws;
    a.ph_lo = 0; a.ph_hi = N_PHASES;
#define LAUNCH_PH(k) do { static bool init_##k = false; if (!init_##k) { (void)hipFuncSetAttribute((const void*)mk_phase<k>, hipFuncAttributeMaxDynamicSharedMemorySize, LDS_BYTES); init_##k = true; } \
        hipLaunchKernelGGL(mk_phase<k>, dim3(grid), dim3(NTHR), LDS_BYTES, stream, a); } while (0)
    LAUNCH_PH(0); LAUNCH_PH(1); LAUNCH_PH(2); LAUNCH_PH(3); LAUNCH_PH(4); LAUNCH_PH(5); LAUNCH_PH(6); LAUNCH_PH(7); LAUNCH_PH(8); LAUNCH_PH(9);
    LAUNCH_PH(10); LAUNCH_PH(11); LAUNCH_PH(12); LAUNCH_PH(13); LAUNCH_PH(14); LAUNCH_PH(15); LAUNCH_PH(16); LAUNCH_PH(17); LAUNCH_PH(18);
#undef LAUNCH_PH
}
```

```cpp
#include <hip/hip_runtime.h>
#include <stdint.h>
#include <stdio.h>

typedef unsigned short bf16;
typedef float f32x4 __attribute__((ext_vector_type(4)));
typedef unsigned u32x4 __attribute__((ext_vector_type(4)));
typedef unsigned u32x2 __attribute__((ext_vector_type(2)));
#define LAS __attribute__((address_space(3)))

constexpr int NB = 8, S = 8192, D = 1024, M = NB * S;
constexpr int HD = 64;
constexpr int FFH = 2816;
constexpr int EVEN_IN = 3404, ODD_IN = 1952;
constexpr int Y0P = 3584;
constexpr int Y0_FQ = 0, Y0_FK = 512, Y0_FV = 1024, Y0_DQ = 1536, Y0_DK = 2048, Y0_DV = 2560, Y0_IQ = 3072, Y0_IK = 3328, Y0_FF = 3392, Y0_IW = 3400;
constexpr int Y1P = 2048;
constexpr int Y1_CQ = 0, Y1_CK = 512, Y1_CV = 1024, Y1_MCQ = 1536, Y1_MCKV = 1792, Y1_MKR = 1920;
constexpr int MQP = 768, MKVP = 1024;
constexpr float RMS_EPS = 1e-6f;
constexpr float LAMBDA_INIT = 0.35550906759309494f;
constexpr int NTHR = 512;
constexpr int LDS_BYTES = 144 * 1024, LDS_CTL_OFF = 144 * 1024 - 256;
constexpr int CW_KMAX = 12288;
constexpr int CW_Q = 8192;
constexpr int CW_BAR = 4096;

constexpr size_t MiB = 1u << 20;
constexpr size_t WS_CTL = 0;
constexpr size_t WS_WIN0 = 2 * MiB;
constexpr size_t WS_WOUT0 = 9 * MiB;
constexpr size_t WS_WGU0 = 11 * MiB;
constexpr size_t WS_WDN0 = 22 * MiB;
constexpr size_t WS_WIN1 = 28 * MiB;
constexpr size_t WS_WUQ = 32 * MiB;
constexpr size_t WS_WUKV = 33 * MiB;
constexpr size_t WS_WOUT1 = 34 * MiB;
constexpr size_t WS_WGU1 = 36 * MiB;
constexpr size_t WS_WDN1 = 47 * MiB;
constexpr size_t WS_SQA = 53 * MiB;
constexpr size_t WS_SQB = 54 * MiB;
constexpr size_t WS_ROPE = 56 * MiB;
constexpr size_t WS_TAB = 57 * MiB;
constexpr size_t WS_AUX = 58 * MiB;
constexpr size_t WS_LC = 62 * MiB;
constexpr size_t WS_SSQ = 64 * MiB;
constexpr size_t WS_KR = 68 * MiB;
constexpr size_t WS_XB = 72 * MiB;
constexpr size_t WS_MIX = 200 * MiB;
constexpr size_t WS_MASK = 328 * MiB;
constexpr size_t WS_BIG = 392 * MiB;
constexpr size_t WS_Y1 = WS_BIG;
constexpr size_t WS_MQ = WS_BIG + 256 * MiB;
constexpr size_t WS_MKV = WS_BIG + 352 * MiB;
constexpr size_t WS_END = WS_BIG + 480 * MiB;

#define WAVE_LDS_SYNC() asm volatile("s_waitcnt vmcnt(0) lgkmcnt(0)" ::: "memory")
__device__ __forceinline__ float bf2f(bf16 v) { return __uint_as_float(((unsigned)v) << 16); }
__device__ __forceinline__ bf16 f2bf(float f) { unsigned u = __float_as_uint(f); return (bf16)((u + 0x7fffu + ((u >> 16) & 1u)) >> 16); }
__device__ __forceinline__ unsigned pk2(float lo, float hi) { return (unsigned)f2bf(lo) | ((unsigned)f2bf(hi) << 16); }
__device__ __forceinline__ float wave_sum(float v) {
#pragma unroll
    for (int o = 1; o < 64; o <<= 1) v += __shfl_xor(v, o);
    return v;
}
__device__ __forceinline__ int t5_bucket_dev(int dist) {
    if (dist < 16) return dist;
    float d = (float)dist;
    int lb = 16 + (int)(logf(d / 16.0f) / 2.0794415416798357f * 16.0f);
    return lb < 31 ? lb : 31;
}

__device__ __forceinline__ int lane_id_v() { int l; asm volatile("v_mbcnt_lo_u32_b32 %0, -1, 0\n\tv_mbcnt_hi_u32_b32 %0, -1, %0" : "=v"(l)); return l & 63; }
#define XB_TMO      128
#define XB_XCNT(j)  (256  + 64 * (j))
#define XB_XSUB(j)  (1280 + 64 * (j))
#define XB_XGEN(j)  (2304 + 64 * (j))
#define XB_TOP      3328
#define XB_TOPGEN   3392
#define XCD_BAR_WORDS 3456
#define XB_SPIN_CAP (1u << 18)

__device__ __forceinline__ unsigned xb_ld(unsigned* p)              { return __hip_atomic_load(p, __ATOMIC_RELAXED, __HIP_MEMORY_SCOPE_AGENT); }
__device__ __forceinline__ unsigned xb_add(unsigned* p, unsigned v) { return __hip_atomic_fetch_add(p, v, __ATOMIC_RELAXED, __HIP_MEMORY_SCOPE_AGENT); }
__device__ __forceinline__ unsigned xb_xcc_id() { return (unsigned)__builtin_amdgcn_s_getreg((3 << 11) | 20) & 0xFu; }
#define XB_SPIN(cond, bar) do { unsigned _sp = 0; while (cond) { __builtin_amdgcn_s_sleep(1); \
    if ((++_sp & 255u) == 0u) { if (xb_ld(&(bar)[XB_TMO])) break; if (_sp > XB_SPIN_CAP) { atomicAdd(&(bar)[XB_TMO], 1u); break; } } } } while (0)

struct XcdBarrier {
    unsigned* bar; unsigned x; int wave;
    volatile LAS unsigned* st;
};

__device__ __forceinline__ XcdBarrier xcd_barrier_post(unsigned* bar, volatile LAS unsigned* st, int wave) {
    XcdBarrier b; b.bar = bar; b.x = xb_xcc_id(); b.st = st; b.wave = wave;
    if (wave == 0 && lane_id_v() == 0) (void)xb_add(&bar[XB_XCNT(b.x)], 1u);
    return b;
}
__device__ __forceinline__ void xcd_barrier_complete(unsigned* bar, unsigned x, unsigned& nloc, unsigned& nx) {
    const unsigned G = gridDim.x * gridDim.y * gridDim.z;
    unsigned sum, cnt, mine, sp = 0u;
    for (;;) {
        sum = 0u; cnt = 0u; mine = 0u;
#pragma unroll
        for (unsigned j = 0; j < 16; ++j) { const unsigned c = xb_ld(&bar[XB_XCNT(j)]); sum += c; cnt += (c > 0u) ? 1u : 0u; mine = (j == x) ? c : mine; }
        if (sum == G) break;
        __builtin_amdgcn_s_sleep(1);
        if ((++sp & 255u) == 0u) { if (xb_ld(&bar[XB_TMO])) break; if (sp > XB_SPIN_CAP) { atomicAdd(&bar[XB_TMO], 1u); break; } }
    }
    nloc = mine > 0u ? mine : 1u; nx = cnt > 0u ? cnt : 1u;
}

__device__ __forceinline__ void xcd_barrier(const XcdBarrier& b) {
    asm volatile("s_waitcnt vmcnt(0)" ::: "memory");
    __syncthreads();
    if (b.wave == 0 && lane_id_v() == 0) {
        unsigned* bar = b.bar;
        __builtin_amdgcn_s_waitcnt(0);
        unsigned nloc = b.st[0], nx = b.st[1];
        if (nloc == 0u) { xcd_barrier_complete(bar, b.x, nloc, nx); b.st[0] = nloc; b.st[1] = nx; }
        const unsigned old = xb_add(&bar[XB_XSUB(b.x)], 1u);
        const unsigned gen = old / nloc;
        if (old + 1u == (gen + 1u) * nloc) {
            __builtin_amdgcn_fence(__ATOMIC_RELEASE, "agent");
            asm volatile("s_waitcnt vmcnt(0)" ::: "memory");
            const unsigned og = xb_add(&bar[XB_TOP], 1u);
            const unsigned tg = og / nx;
            if (og + 1u == (tg + 1u) * nx) xb_add(&bar[XB_TOPGEN], 1u);
            else XB_SPIN(xb_ld(&bar[XB_TOPGEN]) == tg, bar);
            __builtin_amdgcn_fence(__ATOMIC_ACQUIRE, "agent");
            xb_add(&bar[XB_XGEN(b.x)], 1u);
            asm volatile("s_waitcnt vmcnt(0)" ::: "memory");
        } else {
            XB_SPIN(xb_ld(&bar[XB_XGEN(b.x)]) == gen, bar);
            __builtin_amdgcn_fence(__ATOMIC_ACQUIRE, "agent");
            asm volatile("s_waitcnt vmcnt(0)" ::: "memory");
        }
    }
    __syncthreads();
}

namespace pg8 {
#define PG8_LAS __attribute__((address_space(3)))
typedef unsigned short bf16_t;
typedef short bf16x8 __attribute__((ext_vector_type(8)));
typedef float f32x4 __attribute__((ext_vector_type(4)));
typedef unsigned u32x4 __attribute__((ext_vector_type(4)));
constexpr int BM = 256, BK = 64, HALF = 128, HTB = HALF * BK * 2  , STAGE_BYTES = 8 * HTB, NXCD = 8, WGM = 8;

__host__ __device__ __forceinline__ int lds_byte(int r, int c) { const int st = (r >> 4) * 2 + (c >> 5), rr = r & 15, cc = c & 31, ob = rr * 64 + cc * 2; return st * 1024 + (ob ^ (((ob >> 9) & 1) << 5)); }
__host__ __device__ __forceinline__ void stage_rc(int b, int& R, int& C) { const int st = b / 1024, sb = b % 1024, swz = sb ^ (((sb >> 9) & 1) << 5); R = (st >> 1) * 16 + swz / 64; C = (st & 1) * 32 + (swz % 64) / 2; }
__host__ __device__ __forceinline__ int perm32(int rho) { const int n = rho >> 4, i = rho & 15; return 8 * (i >> 2) + 4 * n + (i & 3); }

template <int V> struct BoolI { static constexpr int value = V; };
template <bool V> struct BoolC2 { static constexpr bool value = V; };
struct Unit { int pm, pn; };
struct Gemm { const bf16_t* A; const bf16_t* Bt; int M, N, K, lda, ldb; };

struct StaticOrder {
    int nM, nN, nwg, G, c;
    __host__ __device__ void init(int M, int N, int G_, int c_) { nM = M / BM; nN = N / BM; nwg = nM * nN; G = G_; c = c_; }
    __host__ __device__ bool next(int i, Unit& u) const {
        const long L = (long)i * G + c; if (L >= nwg) return false;
        int wgid = (int)L; { const int q = nwg / NXCD, r = nwg % NXCD, xcd = wgid % NXCD, off = wgid / NXCD; wgid = (xcd < r ? xcd * (q + 1) : r * (q + 1) + (xcd - r) * q) + off; }
        const int nig = WGM * nN, gid = wgid / nig, fm = gid * WGM, gsz = (nM - fm) < WGM ? (nM - fm) : WGM;
        u.pm = fm + ((wgid % nig) % gsz); u.pn = (wgid % nig) / gsz; return true;
    }
    __device__ __forceinline__ void a_ready(const Unit&) const {}
    __device__ __forceinline__ void done(const Unit&) const {}
};


__device__ __forceinline__ unsigned cvt_pk_bf16(float lo, float hi) { unsigned r; asm volatile("v_cvt_pk_bf16_f32 %0, %1, %2" : "=v"(r) : "v"(lo), "v"(hi)); return r; }
__device__ __forceinline__ float row_scale16(const float* ssq, int row, float inv_n) {
    const f32x4* p = (const f32x4*)(ssq + (size_t)row * 16);
    const f32x4 a = p[0], b = p[1], c = p[2], d = p[3];
    float s = a.x; s += a.y; s += a.z; s += a.w; s += b.x; s += b.y; s += b.z; s += b.w; s += c.x; s += c.y; s += c.z; s += c.w; s += d.x; s += d.y; s += d.z; s += d.w;
    return __builtin_amdgcn_rsqf(s * inv_n + 1e-6f);
}
__device__ __forceinline__ float row_scale4(const float* ssq, int row, float inv_n) {
    const f32x4 a = *(const f32x4*)(ssq + (size_t)row * 4);
    return __builtin_amdgcn_rsqf(((a.x + a.y) + (a.z + a.w)) * inv_n + 1e-6f);
}
__device__ __forceinline__ float row_ms16(const float* ssq, int row, float inv_n) {
    const f32x4* p = (const f32x4*)(ssq + (size_t)row * 16);
    const f32x4 a = p[0], b = p[1], c = p[2], d = p[3];
    float s = a.x; s += a.y; s += a.z; s += a.w; s += b.x; s += b.y; s += b.z; s += b.w; s += c.x; s += c.y; s += c.z; s += c.w; s += d.x; s += d.y; s += d.z; s += d.w;
    return s * inv_n + 1e-6f;
}
__device__ __forceinline__ f32x4 row_quad(const float* ssq, int row, int fq) { return *(const f32x4*)(ssq + (size_t)row * 16 + 4 * fq); }
__device__ __forceinline__ float row_ms_from_quad(f32x4 a, float inv_n) {
    float s = a.x; s += a.y; s += a.z; s += a.w;
    s += __shfl_xor(s, 16); s += __shfl_xor(s, 32);
    return s * inv_n + 1e-6f;
}
__device__ __forceinline__ float dot4(f32x4 v) { return (v.x * v.x + v.y * v.y) + (v.z * v.z + v.w * v.w); }

struct EpiScale {
    static constexpr bool PERM = true, AFTER_DRAIN = false;
    bf16_t* O; int ldo; const float* ssq; float* aux; int aux_pn; float* sA; int pnA; float* sB; int pnB;
    __device__ __forceinline__ void operator()(const f32x4 (&acc)[2][2][4][2], const Unit& u, int wr, int wc, int fr, int fq) const {
        float rsv[2][4];
        {
            f32x4 qd[2][4];
#pragma unroll
            for (int ai = 0; ai < 2; ++ai)
#pragma unroll
                for (int m = 0; m < 4; ++m) qd[ai][m] = row_quad(ssq, u.pm * BM + ai * HALF + wr * 64 + m * 16 + fr, fq);
#pragma unroll
            for (int ai = 0; ai < 2; ++ai)
#pragma unroll
                for (int m = 0; m < 4; ++m) asm volatile("" : "+v"(qd[ai][m]));
#pragma unroll
            for (int ai = 0; ai < 2; ++ai)
#pragma unroll
                for (int m = 0; m < 4; ++m) rsv[ai][m] = __builtin_amdgcn_rsqf(row_ms_from_quad(qd[ai][m], 1.0f / 1024.0f));
        }
#pragma unroll
        for (int ai = 0; ai < 2; ++ai)
#pragma unroll
            for (int m = 0; m < 4; ++m) {
                const int row = u.pm * BM + ai * HALF + wr * 64 + m * 16 + fr;
                const float rs = rsv[ai][m];
                float s0 = 0.f, s1 = 0.f;
#pragma unroll
                for (int bj = 0; bj < 2; ++bj) {
                    f32x4 v0, v1;
#pragma unroll
                    for (int j = 0; j < 4; ++j) { v0[j] = acc[ai][bj][m][0][j] * rs; v1[j] = acc[ai][bj][m][1][j] * rs; }
                    const int col = u.pn * BM + bj * HALF + wc * 32 + 8 * fq;
                    u32x4 w; w.x = cvt_pk_bf16(v0[0], v0[1]); w.y = cvt_pk_bf16(v0[2], v0[3]); w.z = cvt_pk_bf16(v1[0], v1[1]); w.w = cvt_pk_bf16(v1[2], v1[3]);
                    *(u32x4*)(O + (size_t)row * ldo + col) = w;
                    if (bj == 0 && u.pn == aux_pn && wc == 2) {
                        const f32x4 a0 = acc[ai][bj][m][0] * rs, a1 = acc[ai][bj][m][1] * rs;
                        if (fq == 0) { *(f32x4*)(aux + (size_t)row * 16) = a0; *(f32x4*)(aux + (size_t)row * 16 + 4) = a1; }
                        if (fq == 1) { *(f32x4*)(aux + (size_t)row * 16 + 8) = a0; }
                    }
                    if (u.pn == pnA || u.pn == pnB) { const f32x4 b0 = acc[ai][bj][m][0] * rs, b1 = acc[ai][bj][m][1] * rs; const float q = dot4(b0) + dot4(b1); if (bj == 0) s0 = q; else s1 = q; }
                }
                if (u.pn == pnA) { float s = s0 + s1; s += __shfl_xor(s, 16); s += __shfl_xor(s, 32); if (fq == 0) sA[(size_t)row * 4 + wc] = s; }
                if (u.pn == pnB) { float s = s0; s += __shfl_xor(s, 16); s += __shfl_xor(s, 32); if (fq == 0) sB[(size_t)row * 4 + wc] = s; }
            }
    }
};
template <bool RES_BF16, bool OUT_F32>
struct EpiResid {
    static constexpr bool PERM = true, AFTER_DRAIN = false;
    const float* resid; float* xout; bf16_t* xb; float* ssq;
    __device__ __forceinline__ void operator()(const f32x4 (&acc)[2][2][4][2], const Unit& u, int wr, int wc, int fr, int fq) const {
#pragma unroll
        for (int ai = 0; ai < 2; ++ai) {
            u32x4 rw[4][2];
            if (RES_BF16) {
#pragma unroll
                for (int m = 0; m < 4; ++m)
#pragma unroll
                    for (int bj = 0; bj < 2; ++bj)
                        rw[m][bj] = *(const u32x4*)(xb + (size_t)(u.pm * BM + ai * HALF + wr * 64 + m * 16 + fr) * 1024 + u.pn * BM + bj * HALF + wc * 32 + 8 * fq);
#pragma unroll
                for (int m = 0; m < 4; ++m)
#pragma unroll
                    for (int bj = 0; bj < 2; ++bj) asm volatile("" : "+v"(rw[m][bj]));
            }
#pragma unroll
            for (int m = 0; m < 4; ++m) {
                const int row = u.pm * BM + ai * HALF + wr * 64 + m * 16 + fr;
                float s = 0.f;
#pragma unroll
                for (int bj = 0; bj < 2; ++bj) {
                    const size_t off = (size_t)row * 1024 + u.pn * BM + bj * HALF + wc * 32 + 8 * fq;
                    f32x4 r0, r1;
                    if (RES_BF16) {
                        const u32x4 w_ = rw[m][bj];
                        r0 = (f32x4){__uint_as_float(w_.x << 16), __uint_as_float(w_.x & 0xffff0000u), __uint_as_float(w_.y << 16), __uint_as_float(w_.y & 0xffff0000u)};
                        r1 = (f32x4){__uint_as_float(w_.z << 16), __uint_as_float(w_.z & 0xffff0000u), __uint_as_float(w_.w << 16), __uint_as_float(w_.w & 0xffff0000u)};
                    } else { r0 = *(const f32x4*)(resid + off); r1 = *(const f32x4*)(resid + off + 4); }
                    f32x4 v0, v1;
#pragma unroll
                    for (int j = 0; j < 4; ++j) { v0[j] = acc[ai][bj][m][0][j] + r0[j]; v1[j] = acc[ai][bj][m][1][j] + r1[j]; }
                    if (OUT_F32) { *(f32x4*)(xout + off) = v0; *(f32x4*)(xout + off + 4) = v1; }
                    else {
                        u32x4 w; w.x = cvt_pk_bf16(v0[0], v0[1]); w.y = cvt_pk_bf16(v0[2], v0[3]); w.z = cvt_pk_bf16(v1[0], v1[1]); w.w = cvt_pk_bf16(v1[2], v1[3]);
                        *(u32x4*)(xb + off) = w;
                    }
                    s += dot4(v0) + dot4(v1);
                }
                s += __shfl_xor(s, 16); s += __shfl_xor(s, 32);
                if (fq == 0) ssq[(size_t)row * 16 + u.pn * 4 + wc] = s;
            }
        }
    }
};
__device__ __forceinline__ float silu_fast(float x) { return x * __builtin_amdgcn_rcpf(1.0f + __expf(-x)); }
struct EpiGU {
    static constexpr bool PERM = true, AFTER_DRAIN = false;
    bf16_t* Hd; int ldh; const float* ssq;
    __device__ __forceinline__ void operator()(const f32x4 (&acc)[2][2][4][2], const Unit& u, int wr, int wc, int fr, int fq) const {
        float xv[2][4];
        {
            f32x4 qd[2][4];
#pragma unroll
            for (int ai = 0; ai < 2; ++ai)
#pragma unroll
                for (int m = 0; m < 4; ++m) qd[ai][m] = row_quad(ssq, u.pm * BM + ai * HALF + wr * 64 + m * 16 + fr, fq);
#pragma unroll
            for (int ai = 0; ai < 2; ++ai)
#pragma unroll
                for (int m = 0; m < 4; ++m) asm volatile("" : "+v"(qd[ai][m]));
#pragma unroll
            for (int ai = 0; ai < 2; ++ai)
#pragma unroll
                for (int m = 0; m < 4; ++m) xv[ai][m] = row_ms_from_quad(qd[ai][m], 1.0f / 1024.0f);
        }
#pragma unroll
        for (int ai = 0; ai < 2; ++ai)
#pragma unroll
            for (int m = 0; m < 4; ++m) {
                const int row = u.pm * BM + ai * HALF + wr * 64 + m * 16 + fr;
                const float x = xv[ai][m], rs = __builtin_amdgcn_rsqf(x);
                const float ea = -1.4426950408889634f * rs;
                float h[8];
#pragma unroll
                for (int n = 0; n < 2; ++n)
#pragma unroll
                    for (int j = 0; j < 4; ++j) {
                        const float g = acc[ai][0][m][n][j], uu = acc[ai][1][m][n][j];
                        const float e = __builtin_amdgcn_exp2f(g * ea);
                        const float q = __builtin_amdgcn_rcpf(__builtin_fmaf(e, x, x));
                        h[n * 4 + j] = (g * uu) * q;
                    }
                u32x4 w; w.x = cvt_pk_bf16(h[0], h[1]); w.y = cvt_pk_bf16(h[2], h[3]); w.z = cvt_pk_bf16(h[4], h[5]); w.w = cvt_pk_bf16(h[6], h[7]);
                *(u32x4*)(Hd + (size_t)row * ldh + u.pn * HALF + wc * 32 + 8 * fq) = w;
            }
    }
};

struct EpiMkv {
    static constexpr bool PERM = true, AFTER_DRAIN = false;
    bf16_t* O; int ldo; const float* sq; float inv_n;
    __device__ __forceinline__ void operator()(const f32x4 (&acc)[2][2][4][2], const Unit& u, int wr, int wc, int fr, int fq) const {
        float rsv[2][4];
#pragma unroll
        for (int ai = 0; ai < 2; ++ai)
#pragma unroll
            for (int m = 0; m < 4; ++m) rsv[ai][m] = row_scale4(sq, u.pm * BM + ai * HALF + wr * 64 + m * 16 + fr, inv_n);
#pragma unroll
        for (int ai = 0; ai < 2; ++ai)
#pragma unroll
            for (int m = 0; m < 4; ++m) { float t_ = rsv[ai][m]; asm volatile("" : "+v"(t_)); rsv[ai][m] = t_; }
#pragma unroll
        for (int ai = 0; ai < 2; ++ai)
#pragma unroll
            for (int m = 0; m < 4; ++m) {
                const int row = u.pm * BM + ai * HALF + wr * 64 + m * 16 + fr;
                const float rs = rsv[ai][m];
#pragma unroll
                for (int bj = 0; bj < 2; ++bj) {
                    f32x4 v0, v1;
#pragma unroll
                    for (int j = 0; j < 4; ++j) { v0[j] = acc[ai][bj][m][0][j] * rs; v1[j] = acc[ai][bj][m][1][j] * rs; }
                    u32x4 w; w.x = cvt_pk_bf16(v0[0], v0[1]); w.y = cvt_pk_bf16(v0[2], v0[3]); w.z = cvt_pk_bf16(v1[0], v1[1]); w.w = cvt_pk_bf16(v1[2], v1[3]);
                    *(u32x4*)(O + (size_t)row * ldo + u.pn * BM + bj * HALF + wc * 32 + 8 * fq) = w;
                }
            }
    }
};

template <class Epi, class Sched, bool ALIGN_EPI = false, bool SP2 = false>
__device__ __forceinline__ void gemm_phase(PG8_LAS unsigned char* lds, const Gemm g, const Sched& S, const Epi& E, const int wid) {
    const int lane = lane_id_v(), tid = wid * 64 + lane,
              wr = wid >> 2, wc = wid & 3, fr = lane & 15, fq = lane >> 4;
    const int K = g.K, nt = K / BK;
    unsigned voffA[2], voffB[2];
#pragma unroll
    for (int i = 0; i < 2; ++i) { int R, C; stage_rc(tid * 16 + i * 8192, R, C); const int Rb = Epi::PERM ? ((R & ~31) + perm32(R & 31)) : R;
        voffA[i] = (unsigned)(R * g.lda + C) * 2u; voffB[i] = (unsigned)(Rb * g.ldb + C) * 2u; }
    const size_t kstep = (size_t)(BK * 2);
    const size_t hstepA = (size_t)HALF * g.lda * 2, hstepB = (size_t)HALF * g.ldb * 2;
    const size_t tstepA = 2 * hstepA, tstepB = 2 * hstepB;
    const unsigned ldsw = (unsigned)wid * 1024u;
    const int aoff = lds_byte(wr * 64 + fr, fq * 8), boff = lds_byte(wc * 32 + fr, fq * 8);
#define PG8_SA(b, h) (((b) * 2 + (h)) * HTB)
#define PG8_SB(b, h) ((4 + (b) * 2 + (h)) * HTB)
#define PG8_STAGE(bufoff, gbase, voff) do { _Pragma("unroll") for (int _i = 0; _i < 2; ++_i) \
        __builtin_amdgcn_global_load_lds((const unsigned*)((const char*)(gbase) + (voff)[_i]), (PG8_LAS unsigned*)(lds + (bufoff) + ldsw + _i * 8192), 16, 0, 0); } while (0)
#define PG8_LDA(dst, b, h) do { _Pragma("unroll") for (int m = 0; m < 4; ++m) _Pragma("unroll") for (int k = 0; k < 2; ++k) dst[m][k] = *(const PG8_LAS bf16x8*)(lds + PG8_SA(b, h) + aoff + m * 2048 + k * 1024); } while (0)
#define PG8_LDB(dst, b, h) do { _Pragma("unroll") for (int n = 0; n < 2; ++n) _Pragma("unroll") for (int k = 0; k < 2; ++k) dst[n][k] = *(const PG8_LAS bf16x8*)(lds + PG8_SB(b, h) + boff + n * 2048 + k * 1024); } while (0)
#define PG8_MMA(ai, bj, At, Bt) do { __builtin_amdgcn_s_setprio(1); _Pragma("unroll") for (int m = 0; m < 4; ++m) _Pragma("unroll") for (int n = 0; n < 2; ++n) _Pragma("unroll") for (int k = 0; k < 2; ++k) \
        acc[ai][bj][m][n] = __builtin_amdgcn_mfma_f32_16x16x32_bf16(Bt[n][k], At[m][k], acc[ai][bj][m][n], 0, 0, 0); __builtin_amdgcn_s_setprio(0); } while (0)
#define PG8_WAIT_V(n) asm volatile("s_waitcnt vmcnt(" #n ")" ::: "memory")
#define PG8_WAIT_L(n) asm volatile("s_waitcnt lgkmcnt(" #n ")" ::: "memory")
#define PG8_BAR __builtin_amdgcn_s_barrier()
#define PG8_SCHED __builtin_amdgcn_sched_barrier(0)
    Unit cur, nxt; int ui = 0;
    if (!S.next(0, cur)) return;
    f32x4 acc[2][2][4][2];
#pragma unroll
    for (int a = 0; a < 2; ++a)
#pragma unroll
        for (int b = 0; b < 2; ++b)
#pragma unroll
            for (int m = 0; m < 4; ++m)
#pragma unroll
                for (int n = 0; n < 2; ++n) acc[a][b][m][n] = (f32x4){0.f, 0.f, 0.f, 0.f};
    bf16x8 At[4][2], B0[2][2], B1[2][2];
    const char* cA = (const char*)g.A + (size_t)cur.pm * tstepA; const char* cB = (const char*)g.Bt + (size_t)cur.pn * tstepB;
    S.a_ready(cur);
    if constexpr (SP2) {
        PG8_STAGE(PG8_SB(0, 0), cB, voffB); PG8_STAGE(PG8_SB(0, 1), cB + hstepB, voffB); PG8_STAGE(PG8_SA(0, 0), cA, voffA); PG8_STAGE(PG8_SA(0, 1), cA + hstepA, voffA);
        if (wr == 1) PG8_BAR;
        PG8_WAIT_V(2); PG8_BAR;
        PG8_STAGE(PG8_SB(1, 0), cB + kstep, voffB); PG8_STAGE(PG8_SA(1, 0), cA + kstep, voffA); PG8_STAGE(PG8_SB(1, 1), cB + hstepB + kstep, voffB);
        PG8_WAIT_V(6); PG8_BAR;
    } else {
        PG8_STAGE(PG8_SB(0, 0), cB, voffB); PG8_STAGE(PG8_SA(0, 0), cA, voffA); PG8_STAGE(PG8_SB(0, 1), cB + hstepB, voffB); PG8_STAGE(PG8_SA(0, 1), cA + hstepA, voffA);
        if (wr == 1) PG8_BAR;
        PG8_WAIT_V(4); PG8_BAR;
        PG8_STAGE(PG8_SB(1, 0), cB + kstep, voffB); PG8_STAGE(PG8_SA(1, 0), cA + kstep, voffA); PG8_STAGE(PG8_SB(1, 1), cB + hstepB + kstep, voffB);
        PG8_WAIT_V(6); PG8_BAR;
    }
    for (;;) {
        const bool has_next = S.next(ui + 1, nxt);
        const char* nA = has_next ? (const char*)g.A + (size_t)nxt.pm * tstepA : cA; const char* nB = has_next ? (const char*)g.Bt + (size_t)nxt.pn * tstepB : cB;
        for (int t = 0; t < nt; t += 2) {
            const bool last = (t == nt - 2);
            const char* a1 = cA + (size_t)(t + 1) * kstep;
            const char* a2 = last ? nA : cA + (size_t)(t + 2) * kstep; const char* b2 = last ? nB : cB + (size_t)(t + 2) * kstep;
            const char* a3 = a2 + kstep; const char* b3 = b2 + kstep;
            if (last && has_next) S.a_ready(nxt);
            if constexpr (SP2) {
            PG8_LDB(B0, 0, 0); PG8_LDB(B1, 0, 1); PG8_SCHED; PG8_LDA(At, 0, 0); PG8_STAGE(PG8_SA(1, 1), a1 + hstepA, voffA);
            PG8_WAIT_V(8); PG8_WAIT_L(0); PG8_BAR; PG8_MMA(0, 0, At, B0); PG8_MMA(0, 1, At, B1); PG8_BAR; PG8_SCHED;
            PG8_LDA(At, 0, 1); PG8_STAGE(PG8_SB(0, 0), b2, voffB); PG8_STAGE(PG8_SB(0, 1), b2 + hstepB, voffB); PG8_STAGE(PG8_SA(0, 0), a2, voffA);
            PG8_WAIT_V(8); PG8_WAIT_L(0); PG8_BAR; PG8_MMA(1, 0, At, B0); PG8_MMA(1, 1, At, B1); PG8_BAR; PG8_SCHED;
            PG8_LDB(B0, 1, 0); PG8_LDB(B1, 1, 1); PG8_SCHED; PG8_LDA(At, 1, 0); PG8_STAGE(PG8_SA(0, 1), a2 + hstepA, voffA);
            PG8_WAIT_V(8); PG8_WAIT_L(0); PG8_BAR; PG8_MMA(0, 0, At, B0); PG8_MMA(0, 1, At, B1); PG8_BAR; PG8_SCHED;
            PG8_LDA(At, 1, 1); PG8_STAGE(PG8_SB(1, 0), b3, voffB); PG8_STAGE(PG8_SB(1, 1), b3 + hstepB, voffB); PG8_STAGE(PG8_SA(1, 0), a3, voffA);
            PG8_WAIT_V(8); PG8_WAIT_L(0); PG8_BAR; PG8_MMA(1, 0, At, B0); PG8_MMA(1, 1, At, B1); PG8_BAR; PG8_SCHED;
            } else {
            PG8_LDB(B0, 0, 0); PG8_SCHED; PG8_LDA(At, 0, 0); PG8_STAGE(PG8_SA(1, 1), a1 + hstepA, voffA);
            PG8_WAIT_L(8); PG8_BAR; PG8_WAIT_L(0); PG8_MMA(0, 0, At, B0); PG8_BAR; PG8_SCHED;
            PG8_LDB(B1, 0, 1); PG8_STAGE(PG8_SB(0, 0), b2, voffB);
            PG8_BAR; PG8_WAIT_L(0); PG8_MMA(0, 1, At, B1); PG8_BAR;
            PG8_LDA(At, 0, 1); PG8_STAGE(PG8_SA(0, 0), a2, voffA);
            PG8_BAR; PG8_WAIT_L(0); PG8_MMA(1, 0, At, B0); PG8_BAR; PG8_SCHED;
            PG8_STAGE(PG8_SB(0, 1), b2 + hstepB, voffB);
            PG8_WAIT_V(6); PG8_BAR; PG8_MMA(1, 1, At, B1); PG8_BAR;
            PG8_LDB(B0, 1, 0); PG8_SCHED; PG8_LDA(At, 1, 0); PG8_STAGE(PG8_SA(0, 1), a2 + hstepA, voffA);
            PG8_WAIT_L(8); PG8_BAR; PG8_WAIT_L(0); PG8_MMA(0, 0, At, B0); PG8_BAR; PG8_SCHED;
            PG8_LDB(B1, 1, 1); PG8_STAGE(PG8_SB(1, 0), b3, voffB);
            PG8_BAR; PG8_WAIT_L(0); PG8_MMA(0, 1, At, B1); PG8_BAR;
            PG8_LDA(At, 1, 1); PG8_STAGE(PG8_SA(1, 0), a3, voffA);
            PG8_BAR; PG8_WAIT_L(0); PG8_MMA(1, 0, At, B0); PG8_BAR; PG8_SCHED;
            PG8_STAGE(PG8_SB(1, 1), b3 + hstepB, voffB);
            PG8_WAIT_V(6); PG8_BAR; PG8_MMA(1, 1, At, B1); PG8_BAR;
            }
        }
        if constexpr (ALIGN_EPI) { if (wr == 0) PG8_BAR; }
        if constexpr (!Epi::AFTER_DRAIN) { E(acc, cur, wr, wc, fr, fq); S.done(cur); }
        if (!has_next) break;
#pragma unroll
        for (int a = 0; a < 2; ++a)
#pragma unroll
            for (int b = 0; b < 2; ++b)
#pragma unroll
                for (int m = 0; m < 4; ++m)
#pragma unroll
                    for (int n = 0; n < 2; ++n) acc[a][b][m][n] = (f32x4){0.f, 0.f, 0.f, 0.f};
        cur = nxt; cA = nA; cB = nB; ++ui;
        if constexpr (ALIGN_EPI) { if (wr == 1) PG8_BAR; }
    }
    PG8_WAIT_V(0);
    if constexpr (!ALIGN_EPI) { if (wr == 0) PG8_BAR; }
    PG8_BAR;
    if constexpr (Epi::AFTER_DRAIN) { E.fused(acc, cur, wr, wc, fr, fq, lds, wid, lane); S.done(cur); }
#undef PG8_SA
#undef PG8_SB
#undef PG8_STAGE
#undef PG8_LDA
#undef PG8_LDB
#undef PG8_MMA
#undef PG8_WAIT_V
#undef PG8_WAIT_L
#undef PG8_BAR
#undef PG8_SCHED
}
}


__device__ __forceinline__ int opaque_i(int x) { asm volatile("" : "+v"(x)); return x; }
__device__ __forceinline__ unsigned okey(float f) { const unsigned u = __float_as_uint(f); return (u & 0x80000000u) ? ~u : (u | 0x80000000u); }
namespace att {
typedef short bf16x8 __attribute__((ext_vector_type(8)));
typedef short s16x4 __attribute__((ext_vector_type(4)));
typedef float f32x16 __attribute__((ext_vector_type(16)));
enum { AM_FOX = 0, AM_DSA = 1, AM_DIFF = 2, AM_MLA = 3 };
constexpr float LOG2E = 1.4426950408889634f;
constexpr int OFF_LUT = 126 * 1024, OFF_MISC = OFF_LUT + 1024, ATT_LDS = OFF_MISC + 128;
static_assert(ATT_LDS <= 128 * 1024, "attention LDS map");

__device__ __forceinline__ void glds16(const void* gsrc, unsigned lds_dst) { unsigned keep;
    asm volatile("s_mov_b32 %0, m0\n\ts_mov_b32 m0, %2\n\ts_nop 0\n\tglobal_load_lds_dwordx4 %1, off\n\ts_mov_b32 m0, %0" : "=&s"(keep) : "v"(gsrc), "s"(lds_dst) : "memory"); }
__device__ __forceinline__ void glds4(const void* gsrc, unsigned lds_dst) { unsigned keep;
    asm volatile("s_mov_b32 %0, m0\n\ts_mov_b32 m0, %2\n\ts_nop 0\n\tglobal_load_lds_dword %1, off\n\ts_mov_b32 m0, %0" : "=&s"(keep) : "v"(gsrc), "s"(lds_dst) : "memory"); }
__device__ __forceinline__ void glds16s(const void* sbase, unsigned voff, unsigned lds_dst) { unsigned keep;
    asm volatile("s_mov_b32 %0, m0\n\ts_mov_b32 m0, %3\n\ts_nop 0\n\tglobal_load_lds_dwordx4 %1, %2\n\ts_mov_b32 m0, %0" : "=&s"(keep) : "v"(voff), "s"(sbase), "s"(lds_dst) : "memory"); }
__device__ __forceinline__ void glds4s(const void* sbase, unsigned voff, unsigned lds_dst) { unsigned keep;
    asm volatile("s_mov_b32 %0, m0\n\ts_mov_b32 m0, %3\n\ts_nop 0\n\tglobal_load_lds_dword %1, %2\n\ts_mov_b32 m0, %0" : "=&s"(keep) : "v"(voff), "s"(sbase), "s"(lds_dst) : "memory"); }
struct QPre { unsigned* ctr; unsigned pre; bool issued; };
struct Tens {
    const bf16* Q; int ldq;
    const bf16* K; int ldk;
    const bf16* K2; int ldk2;
    const bf16* V; int ldv;
    const float* lc;
    const unsigned* mask;
    const float* rcos; const float* rsin;
    float kmaxn;
    float scale2;
};
__device__ __forceinline__ float sum32f(float v) { auto rr = __builtin_amdgcn_permlane32_swap(__float_as_uint(v), __float_as_uint(v), false, false); return __uint_as_float(rr[0]) + __uint_as_float(rr[1]); }
__device__ __forceinline__ int crow(int reg, int h) { return (reg & 3) + 8 * (reg >> 2) + 4 * h; }

__device__ __forceinline__ bf16x8 split3_bf16(float v, int h) {
    const unsigned short b0 = f2bf(v); const float r1 = v - __uint_as_float(((unsigned)b0) << 16);
    const unsigned short b1 = f2bf(r1); const float r2 = r1 - __uint_as_float(((unsigned)b1) << 16);
    const unsigned short b2 = f2bf(r2);
    bf16x8 q = {0, 0, 0, 0, 0, 0, 0, 0};
    if (h == 0) { q[0] = (short)b0; q[1] = (short)b1; q[2] = (short)b2; }
    return q;
}
template <int MODE, int DQK, int DV>
__device__ __forceinline__ void attn_pass(LAS unsigned char* lds, const Tens& T, size_t rowbase, int q0, f32x16 (&o)[DV / 32], float& l_out, const int wave, QPre* qp = nullptr) {
    constexpr int NSTEP = DQK / 16, NDB = DV / 32, VROW = DV * 2;
    constexpr float THR = 8.0f;
    constexpr int NSUB = (MODE == AM_FOX) ? 1 : 2;
    constexpr int NRING = (MODE == AM_DIFF) ? 2 : 3;
    constexpr int KB_T = (DQK == 96) ? 12288 : 8192, VB_T = DV * 128, KSL = NSUB * KB_T, VSL = NSUB * VB_T;
    constexpr int OFF_K = 0, OFF_V = NRING * KSL, OFF_CS = OFF_V + NRING * VSL, OFF_MW = OFF_CS + ((MODE == AM_FOX) ? NRING * NSUB * 256 : 0), RING_END = OFF_MW + ((MODE == AM_DSA) ? NRING * NSUB * 2048 : 0);
    static_assert(RING_END <= OFF_LUT, "attention ring");
    const int lane = lane_id_v(), tid = wave * 64 + lane, r = lane & 31, h = lane >> 5;
    const int tq = q0 + wave * 32 + r;
    const int ntile = (q0 + 256) / 64;
    bf16x8 qf[NSTEP];
    {
        const bf16* qp = T.Q + (rowbase + tq) * (size_t)T.ldq + 8 * h;
#pragma unroll
        for (int s = 0; s < NSTEP; ++s) qf[s] = *(const bf16x8*)(qp + 16 * s);
    }
    {
        f32x4 c0 = {1.f, 1.f, 1.f, 1.f}, c1 = c0, s0 = {0.f, 0.f, 0.f, 0.f}, s1 = s0;
        if (MODE == AM_MLA) {
            c0 = *(const f32x4*)(T.rcos + tq * 16 + 8 * h); c1 = *(const f32x4*)(T.rcos + tq * 16 + 8 * h + 4);
            s0 = *(const f32x4*)(T.rsin + tq * 16 + 8 * h); s1 = *(const f32x4*)(T.rsin + tq * 16 + 8 * h + 4);
        }
#pragma unroll
        for (int s = 0; s < NSTEP; ++s) {
            if (MODE == AM_MLA && s == NSTEP - 1) continue;
            bf16x8 a = qf[s];
            if (MODE == AM_MLA && s == NSTEP - 2) {
                bf16x8 b2 = qf[NSTEP - 1];
#pragma unroll
                for (int j = 0; j < 8; ++j) {
                    const float x1 = __uint_as_float(((unsigned)(unsigned short)a[j]) << 16), x2 = __uint_as_float(((unsigned)(unsigned short)b2[j]) << 16);
                    const float cs = j < 4 ? c0[j & 3] : c1[j & 3], sn = j < 4 ? s0[j & 3] : s1[j & 3];
                    a[j] = (short)f2bf((x1 * cs - x2 * sn) * T.scale2); b2[j] = (short)f2bf((x2 * cs + x1 * sn) * T.scale2);
                }
                qf[NSTEP - 1] = b2;
            } else {
#pragma unroll
                for (int j = 0; j < 8; ++j) a[j] = (short)f2bf(__uint_as_float(((unsigned)(unsigned short)a[j]) << 16) * T.scale2);
            }
            qf[s] = a;
        }
    }
    float ct2 = 0.f, bq = 0.f;
    if (MODE == AM_FOX) {
        ct2 = T.lc[(rowbase + tq) * 8] * LOG2E;
        float qs = 0.f;
#pragma unroll
        for (int s = 0; s < NSTEP; ++s)
#pragma unroll
            for (int j = 0; j < 8; ++j) { const float v = __uint_as_float(((unsigned)(unsigned short)qf[s][j]) << 16); qs = fmaf(v, v, qs); }
        qs = sum32f(qs);
        bq = sqrtf(qs) * T.kmaxn * 1.001f + 1.0f;
    }
    const LAS float* lut = (const LAS float*)(lds + OFF_LUT);
    const int dk_key = 8 * wave + (lane >> 3), dk_col = ((lane & 7) ^ ((dk_key >> 1) & 7)) * 8;
    const int dr_key = 16 * wave + (lane >> 2), dr_col = ((lane & 3) ^ ((dr_key >> 2) & 3)) * 8;
    int dv_key[DV / 64], dv_col[DV / 64];
#pragma unroll
    for (int n = 0; n < DV / 64; ++n) {
        if (DV == 64) { dv_key[n] = 8 * wave + (lane >> 3); const int pos = lane & 7; dv_col[n] = (((pos >> 2) ^ ((dv_key[n] >> 1) & 1)) * 32) + (pos & 3) * 8; }
        else          { dv_key[n] = 8 * wave + 4 * n + (lane >> 4); const int pos = lane & 15; dv_col[n] = (((pos >> 2) ^ (dv_key[n] & 3)) * 32) + (pos & 3) * 8; }
    }
    const int dm_q = (wave * 64 + lane) >> 1, dm_kb = lane & 1;
    const unsigned lds0 = (unsigned)(uintptr_t)lds;
#define ATT_LDSADDR(x) ((unsigned)__builtin_amdgcn_readfirstlane((int)(lds0 + (unsigned)(x))))
    const unsigned kvo = (unsigned)(dk_key * T.ldk + dk_col) * 2u, rvo = (unsigned)(dr_key * T.ldk2 + dr_col) * 2u;
    unsigned vvo[DV / 64];
#pragma unroll
    for (int n = 0; n < DV / 64; ++n) vvo[n] = (unsigned)(dv_key[n] * T.ldv + dv_col[n]) * 2u;
    const unsigned cvo = (unsigned)lane * 32u, mvo = (unsigned)(wave * 64 + lane) * 4u;
    const char* const ubK = (const char*)(T.K + rowbase * (size_t)T.ldk);
    const char* const ubK2 = (MODE == AM_MLA) ? (const char*)(T.K2 + rowbase * (size_t)T.ldk2) : nullptr;
    const char* const ubV = (const char*)(T.V + rowbase * (size_t)T.ldv);
    const char* const ubC = (MODE == AM_FOX) ? (const char*)(T.lc + rowbase * 8) : nullptr;
    const char* const ubM = (MODE == AM_DSA) ? (const char*)(T.mask + ((rowbase / S * 128) * (size_t)S + q0) * 2) : nullptr;
#define ATT_DMA(jt, sl, sub) do { const size_t jt_ = (size_t)(jt); \
        glds16s(ubK + jt_ * (size_t)(128 * T.ldk), kvo, ATT_LDSADDR(OFF_K + (sl) * KSL + (sub) * KB_T + wave * 1024)); \
        if (DQK == 96) { if (wave < 4) glds16s(ubK2 + jt_ * (size_t)(128 * T.ldk2), rvo, ATT_LDSADDR(OFF_K + (sl) * KSL + (sub) * KB_T + 8192 + wave * 1024)); } \
        _Pragma("unroll") for (int n_ = 0; n_ < DV / 64; ++n_) \
            glds16s(ubV + jt_ * (size_t)(128 * T.ldv), vvo[n_], ATT_LDSADDR(OFF_V + (sl) * VSL + (sub) * VB_T + (wave * (DV / 64) + n_) * 1024)); \
        if (MODE == AM_FOX) { if (wave == 0) glds4s(ubC + jt_ * 2048, cvo, ATT_LDSADDR(OFF_CS + ((sl) * NSUB + (sub)) * 256)); } \
        if (MODE == AM_DSA) glds4s(ubM + jt_ * (size_t)(S * 8), mvo, ATT_LDSADDR(OFF_MW + ((sl) * NSUB + (sub)) * 2048 + wave * 256)); \
    } while (0)
#define ATT_ISSUE(st_, sl) do { _Pragma("unroll") for (int sb_ = 0; sb_ < NSUB; ++sb_) ATT_DMA(ATT_TILE((st_) * NSUB + sb_), sl, sb_); } while (0)
    const int nvm = 1 + ((DQK == 96 && wave < 4) ? 1 : 0) + DV / 64 + ((MODE == AM_FOX && wave == 0) ? 1 : 0) + ((MODE == AM_DSA) ? 1 : 0);
#define ATT_WAIT_PREV() do { if (NSUB == 1) { if (nvm == 2) asm volatile("s_waitcnt vmcnt(2)" ::: "memory"); else asm volatile("s_waitcnt vmcnt(3)" ::: "memory"); } \
                              else { if (nvm == 2) asm volatile("s_waitcnt vmcnt(4)" ::: "memory"); else asm volatile("s_waitcnt vmcnt(6)" ::: "memory"); } } while (0)
#define ATT_BAR() asm volatile("s_waitcnt lgkmcnt(0)\n\ts_barrier" ::: "memory")
    const unsigned koff = (unsigned)(r * 128), kswz = (unsigned)((r >> 1) & 7);
    const unsigned roff = (unsigned)(8192 + r * 64), rswz = (unsigned)((r >> 2) & 3);
    const int g16 = lane >> 4, qq = (lane & 15) >> 2, pp = lane & 3;
    const int vsw = (DV == 64) ? ((qq >> 1) & 1) : qq;
    const unsigned voff = (unsigned)((4 * (g16 >> 1) + qq) * VROW + (16 * (g16 & 1) + 4 * pp) * 2);
    const LAS unsigned char* kfa[NSTEP]; const LAS unsigned char* vfa[NDB];
#pragma unroll
    for (int s = 0; s < NSTEP; ++s) {
        kfa[s] = (s < 4) ? lds + OFF_K + koff + (((unsigned)(2 * s + h) ^ kswz) * 16) : lds + OFF_K + roff + (((unsigned)(2 * (s - 4) + h) ^ rswz) * 16);
        asm volatile("" : "+v"(kfa[s]));
    }
#pragma unroll
    for (int db = 0; db < NDB; ++db) { vfa[db] = lds + OFF_V + voff + (unsigned)((db ^ vsw) * 64); asm volatile("" : "+v"(vfa[db])); }

    float m = -64.0f, l = 0.f;
    bf16x8 kone = {0, 0, 0, 0, 0, 0, 0, 0}, qm = kone;
    if (MODE == AM_DSA) { if (h == 0) { kone[0] = (short)0x3F80; kone[1] = (short)0x3F80; kone[2] = (short)0x3F80; } qm = split3_bf16(64.0f, h); }
    f32x16 negm;
#pragma unroll
    for (int rg = 0; rg < 16; ++rg) negm[rg] = 64.0f;
#pragma unroll
    for (int i = 0; i < NDB; ++i) o[i] = f32x16{};
    const int jlast = (q0 + wave * 32) / 64;
    constexpr bool DESC = (MODE == AM_FOX);
#define ATT_TILE(i) (DESC ? (ntile - 1 - (i)) : (i))
    bool wdone = false;
    volatile LAS int* dflag = (volatile LAS int*)(lds + OFF_MISC + 16);
    const int nst = ntile / NSUB;
    ATT_ISSUE(0, 0);
    if (NRING == 3) ATT_ISSUE(1, 1);
    if (NRING == 3) ATT_WAIT_PREV(); else asm volatile("s_waitcnt vmcnt(0)" ::: "memory");
    ATT_BAR();
    auto tile_step = [&](auto slc_, const int st) __attribute__((always_inline)) -> bool {
        constexpr int sl = decltype(slc_)::value;
        { constexpr int sl2 = (sl + NRING - 1) % NRING; if (st + NRING - 1 < nst) ATT_ISSUE(st + NRING - 1, sl2); }
#pragma unroll
        for (int sub = 0; sub < NSUB; ++sub) {
        const int it = st * NSUB + sub;
        const int j = ATT_TILE(it);
        if (qp != nullptr && it == (MODE == AM_FOX ? 1 : ntile - 4)) { if (tid == 0) qp->pre = __hip_atomic_fetch_add(qp->ctr, 1u, __ATOMIC_RELAXED, __HIP_MEMORY_SCOPE_AGENT); qp->issued = true; }
        bool active = (j <= jlast);
        if (MODE == AM_FOX) {
            if (active && !wdone) {
                const float csn = *(const LAS float*)(lds + OFF_CS + (sl * NSUB + sub) * 256 + 63 * 4) * LOG2E;
                if (__all((ct2 - csn) + bq < m - 32.0f)) wdone = true;
            }
            active = active && !wdone;
        }
        if (active) {
            u32x2 mw = {0u, 0u};
            if (MODE == AM_DSA) mw = *(const LAS u32x2*)(lds + OFF_MW + (sl * NSUB + sub) * 2048 + (wave * 32 + r) * 8);
            f32x16 p[2];
            const int kbase = 64 * j;
            const bool diag = (kbase + 63 > q0 + wave * 32);
            const bool nearb = (kbase + 63 + 128 > q0 + wave * 32);
            constexpr bool POSTHOC = (MODE != AM_FOX);
            constexpr float BIG = 65536.0f;
            bool redo = (it == 0);
            float psum;
            for (;;) {
#pragma unroll
            for (int kb = 0; kb < 2; ++kb) {
                if (MODE == AM_FOX) {
                    const float ctm = ct2 - m;
#pragma unroll
                    for (int g = 0; g < 4; ++g) {
                        const f32x4 c = *(const LAS f32x4*)(lds + OFF_CS + (sl * NSUB + sub) * 256 + (32 * kb + 8 * g + 4 * h) * 4);
                        p[kb][4 * g + 0] = fmaf(-LOG2E, c.x, ctm); p[kb][4 * g + 1] = fmaf(-LOG2E, c.y, ctm); p[kb][4 * g + 2] = fmaf(-LOG2E, c.z, ctm); p[kb][4 * g + 3] = fmaf(-LOG2E, c.w, ctm);
                    }
                } else if (MODE == AM_DSA) {
#pragma unroll
                    for (int g = 0; g < 4; ++g) {
                        const unsigned nib = __builtin_amdgcn_ubfe(mw[kb], (unsigned)(8 * g + 4 * h), 4u);
                        const f32x4 t4 = *(const LAS f32x4*)(lds + OFF_LUT + 768 + nib * 16);
                        p[kb][4 * g + 0] = t4.x; p[kb][4 * g + 1] = t4.y; p[kb][4 * g + 2] = t4.z; p[kb][4 * g + 3] = t4.w;
                    }
                    p[kb] = __builtin_amdgcn_mfma_f32_32x32x16_bf16(kone, qm, p[kb], 0, 0, 0);
                }
#pragma unroll
                for (int s = 0; s < NSTEP; ++s) {
                    bf16x8 a;
                    if (s < 4) a = *(const LAS bf16x8*)(kfa[s] + sl * KSL + sub * KB_T + kb * 4096);
                    else       a = *(const LAS bf16x8*)(kfa[s] + sl * KSL + sub * KB_T + kb * 2048);
                    if ((MODE == AM_DIFF || MODE == AM_MLA) && s == 0)
                        asm("v_mfma_f32_32x32x16_bf16 %0, %1, %2, %3" : "=&v"(p[kb]) : "v"(a), "v"(qf[0]), "v"(negm));
                    else
                        p[kb] = __builtin_amdgcn_mfma_f32_32x32x16_bf16(a, qf[s], p[kb], 0, 0, 0);
                }
            }
            if (MODE == AM_DSA || MODE == AM_DIFF) {
                if (nearb) {
                    int dq = tq - kbase - 4 * h; asm volatile("" : "+v"(dq));
#pragma unroll
                    for (int kb = 0; kb < 2; ++kb)
#pragma unroll
                        for (int rg = 0; rg < 16; ++rg) { int dist = dq - (32 * kb + (rg & 3) + 8 * (rg >> 2)); dist = dist < 0 ? 0 : (dist > 128 ? 128 : dist); p[kb][rg] += lut[dist]; }
                }
            }
            if (MODE != AM_DSA && diag) {
                int dq = tq - kbase - 4 * h; asm volatile("" : "+v"(dq));
#pragma unroll
                for (int kb = 0; kb < 2; ++kb)
#pragma unroll
                    for (int rg = 0; rg < 16; ++rg) { if (32 * kb + (rg & 3) + 8 * (rg >> 2) > dq) p[kb][rg] = -INFINITY; }
            }
            if (!POSTHOC || redo) {
                float ta = fmaxf(fmaxf(p[0][0], p[0][1]), p[0][2]), tb = fmaxf(fmaxf(p[1][0], p[1][1]), p[1][2]);
#pragma unroll
                for (int rg = 3; rg < 15; rg += 2) { ta = fmaxf(fmaxf(ta, p[0][rg]), p[0][rg + 1]); tb = fmaxf(fmaxf(tb, p[1][rg]), p[1][rg + 1]); }
                float tmax = fmaxf(fmaxf(ta, tb), fmaxf(p[0][15], p[1][15]));
                { auto rr = __builtin_amdgcn_permlane32_swap(__float_as_uint(tmax), __float_as_uint(tmax), false, false); tmax = fmaxf(__uint_as_float(rr[0]), __uint_as_float(rr[1])); }
                if (POSTHOC || __builtin_expect(__any(tmax > THR), 0)) {
                    const float delta = fmaxf(tmax, 0.f);
                    m += delta;
                    const float alpha = __builtin_amdgcn_exp2f(-delta);
                    l *= alpha;
#pragma unroll
                    for (int kb = 0; kb < 2; ++kb)
#pragma unroll
                        for (int rg = 0; rg < 16; ++rg) p[kb][rg] -= delta;
#pragma unroll
                    for (int i = 0; i < NDB; ++i)
#pragma unroll
                        for (int rg = 0; rg < 16; ++rg) o[i][rg] *= alpha;
                    if (MODE == AM_DIFF || MODE == AM_MLA) {
#pragma unroll
                        for (int rg = 0; rg < 16; ++rg) negm[rg] = -m;
                    }
                    if (MODE == AM_DSA) qm = split3_bf16(-m, h);
                }
            }
            psum = 0.f;
#pragma unroll
            for (int rg = 0; rg < 16; ++rg) { const float e0 = __builtin_amdgcn_exp2f(p[0][rg]), e1 = __builtin_amdgcn_exp2f(p[1][rg]); p[0][rg] = e0; p[1][rg] = e1; psum += e0; psum += e1; }
            if (!POSTHOC || redo) break;
            if (__builtin_expect(!__any(!(psum <= BIG)), 1)) break;
            redo = true;
            }
            l += psum;
            bf16x8 pf[4];
#pragma unroll
            for (int kb = 0; kb < 2; ++kb)
#pragma unroll
                for (int s = 0; s < 2; ++s) {
                    u32x4 w;
                    w.x = pg8::cvt_pk_bf16(p[kb][8 * s + 0], p[kb][8 * s + 1]); w.y = pg8::cvt_pk_bf16(p[kb][8 * s + 2], p[kb][8 * s + 3]);
                    w.z = pg8::cvt_pk_bf16(p[kb][8 * s + 4], p[kb][8 * s + 5]); w.w = pg8::cvt_pk_bf16(p[kb][8 * s + 6], p[kb][8 * s + 7]);
                    pf[2 * kb + s] = __builtin_bit_cast(bf16x8, w);
                }
#pragma unroll
            for (int db = 0; db < NDB; ++db) {
#pragma unroll
                for (int ks = 0; ks < 4; ++ks) {
                    const LAS unsigned char* vp = vfa[db] + sl * VSL + sub * VB_T + (16 * ks) * VROW;
                    const s16x4 lo = __builtin_bit_cast(s16x4, __builtin_amdgcn_ds_read_tr16_b64_v4i16((LAS s16x4*)(vp)));
                    const s16x4 hi = __builtin_bit_cast(s16x4, __builtin_amdgcn_ds_read_tr16_b64_v4i16((LAS s16x4*)(vp + 8 * VROW)));
                    const bf16x8 a = {lo[0], lo[1], lo[2], lo[3], hi[0], hi[1], hi[2], hi[3]};
                    o[db] = __builtin_amdgcn_mfma_f32_32x32x16_bf16(a, pf[ks], o[db], 0, 0, 0);
                }
            }
        }
        }
        if (MODE == AM_FOX) { if (lane == 0) dflag[(st & 1) * 8 + wave] = wdone ? 1 : 0; }
        if (NRING == 3 && st + 2 < nst) ATT_WAIT_PREV(); else asm volatile("s_waitcnt vmcnt(0)" ::: "memory");
        ATT_BAR();
        if (MODE == AM_FOX) {
            int alld = 1;
#pragma unroll
            for (int w_ = 0; w_ < 8; ++w_) alld &= dflag[(st & 1) * 8 + w_];
            if (alld) return false;
        }
        return true;
    };
    for (int st = 0; st < nst; st += NRING) {
        if (!tile_step(pg8::BoolI<0>{}, st)) break;
        if (st + 1 >= nst) break;
        if (!tile_step(pg8::BoolI<1>{}, st + 1)) break;
        if (NRING == 3) {
            if (st + 2 >= nst) break;
            if (!tile_step(pg8::BoolI<(NRING == 3 ? 2 : 0)>{}, st + 2)) break;
        }
    }
    asm volatile("s_waitcnt vmcnt(0)" ::: "memory");
    __syncthreads();
#undef ATT_DMA
#undef ATT_ISSUE
#undef ATT_LDSADDR
#undef ATT_WAIT_PREV
#undef ATT_TILE
#undef ATT_BAR
    l_out = sum32f(l);
}

__device__ __forceinline__ void swap_pair(u32x2& a, u32x2& b) {
    { auto r_ = __builtin_amdgcn_permlane32_swap(a.x, b.x, false, false); a.x = r_[0]; b.x = r_[1]; }
    { auto r_ = __builtin_amdgcn_permlane32_swap(a.y, b.y, false, false); a.y = r_[0]; b.y = r_[1]; }
}
template <int DV>
__device__ __forceinline__ void store_o(bf16* Orow, const f32x16 (&o)[DV / 32], float l, int h) {
    const float il = 1.0f / l;
#pragma unroll
    for (int db = 0; db < DV / 32; ++db)
#pragma unroll
        for (int gp = 0; gp < 2; ++gp) {
            u32x2 a, b;
            a.x = pg8::cvt_pk_bf16(o[db][8 * gp + 0] * il, o[db][8 * gp + 1] * il); a.y = pg8::cvt_pk_bf16(o[db][8 * gp + 2] * il, o[db][8 * gp + 3] * il);
            b.x = pg8::cvt_pk_bf16(o[db][8 * gp + 4] * il, o[db][8 * gp + 5] * il); b.y = pg8::cvt_pk_bf16(o[db][8 * gp + 6] * il, o[db][8 * gp + 7] * il);
            swap_pair(a, b);
            const u32x4 w = {a.x, a.y, b.x, b.y};
            *(u32x4*)(Orow + 32 * db + 16 * gp + 8 * h) = w;
        }
}
__device__ __forceinline__ int next_unit_pre(QPre& qp, unsigned* counters, int per_queue, LAS unsigned char* lds, int slot_off, const int wave) {
    volatile LAS int* slot = (volatile LAS int*)(lds + opaque_i(slot_off));
    const unsigned x = ((unsigned)__builtin_amdgcn_s_getreg((3 << 11) | 20)) & 7u;
    qp.ctr = counters + x * 64;
    if (wave == 0 && lane_id_v() == 0) {
        int res = -1;
        unsigned k0 = 0u;
        if (qp.issued) { if (qp.pre < (unsigned)per_queue) res = (int)(x * (unsigned)per_queue + qp.pre); k0 = 1u; }
        if (res < 0) {
            for (unsigned k = k0; k < 8u; ++k) {
                const unsigned q = (x + k) & 7u;
                if (k > 0 && __hip_atomic_load(counters + q * 64, __ATOMIC_RELAXED, __HIP_MEMORY_SCOPE_AGENT) >= (unsigned)per_queue) continue;
                const unsigned idx = __hip_atomic_fetch_add(counters + q * 64, 1u, __ATOMIC_RELAXED, __HIP_MEMORY_SCOPE_AGENT);
                if (idx < (unsigned)per_queue) { res = (int)(q * (unsigned)per_queue + idx); break; }
            }
        }
        slot[0] = res;
    }
    qp.issued = false;
    __syncthreads();
    const int u = __builtin_amdgcn_readfirstlane(slot[0]);
    __syncthreads();
    return u;
}
__device__ __forceinline__ int next_unit(unsigned* counters, int per_queue, LAS unsigned char* lds, int slot_off, const int wave) {
    volatile LAS int* slot = (volatile LAS int*)(lds + slot_off);
    if (wave == 0 && lane_id_v() == 0) {
        const unsigned x = ((unsigned)__builtin_amdgcn_s_getreg((3 << 11) | 20)) & 7u;
        int res = -1;
        for (unsigned k = 0; k < 8u; ++k) {
            const unsigned q = (x + k) & 7u;
            if (k > 0 && __hip_atomic_load(counters + q * 64, __ATOMIC_RELAXED, __HIP_MEMORY_SCOPE_AGENT) >= (unsigned)per_queue) continue;
            const unsigned idx = __hip_atomic_fetch_add(counters + q * 64, 1u, __ATOMIC_RELAXED, __HIP_MEMORY_SCOPE_AGENT);
            if (idx < (unsigned)per_queue) { res = (int)(q * (unsigned)per_queue + idx); break; }
        }
        slot[0] = res;
    }
    __syncthreads();
    const int u = __builtin_amdgcn_readfirstlane(slot[0]);
    __syncthreads();
    return u;
}
}

namespace dsa {
typedef att::bf16x8 bf16x8;
typedef att::f32x16 f32x16;
constexpr int HROW = 257;
constexpr int OFF_HIST = 0, OFF_GT = 33024, OFF_EQ = OFF_GT + 33024, OFF_PFX = OFF_EQ + 33024, OFF_NEED = OFF_PFX + 128, OFF_SLOT = OFF_NEED + 128, DSA_LDS = OFF_SLOT + 64;


__device__ __forceinline__ void write_mask_T(const LAS unsigned* gsrc, unsigned* maskg, int b, int t0, int tid) {
    const int q = tid & 31, jl = tid >> 5;
#pragma unroll
    for (int k = 0; k < 8; ++k) {
        const int jp = jl + 16 * k;
        u32x2 w; w.x = gsrc[q * HROW + 2 * jp]; w.y = gsrc[q * HROW + 2 * jp + 1];
        *(u32x2*)(maskg + (((size_t)(b * 128 + jp) * S) + t0 + q) * 2) = w;
    }
}
template <int LEVEL>
__device__ __forceinline__ void pass(LAS unsigned char* lds, const bf16* kbase  , int g, int t0, const bf16x8 (&qf)[4][4], const f32x4 lo4, const f32x4 hi4,
                                     int wave, int r, int h2) {
    LAS unsigned* hist = (LAS unsigned*)(lds + OFF_HIST);
    LAS unsigned* gtm = (LAS unsigned*)(lds + OFF_GT);
    LAS unsigned* eqm = (LAS unsigned*)(lds + OFF_EQ);
    const int tq = t0 + r;
    const unsigned pfx = ((const LAS unsigned*)(lds + OFF_PFX))[r];
    const bool selall = tq < 256;
    bf16x8 kf[4], kn[4];
    const bf16* kp = kbase + (size_t)r * Y0P + 8 * h2;
    if (wave <= g) {
#pragma unroll
        for (int s = 0; s < 4; ++s) kf[s] = *(const bf16x8*)(kp + (size_t)(32 * wave) * Y0P + 16 * s);
    }
    for (int kt = wave; kt <= g; kt += 8) {
        if (kt + 8 <= g) {
#pragma unroll
            for (int s = 0; s < 4; ++s) kn[s] = *(const bf16x8*)(kp + (size_t)(32 * (kt + 8)) * Y0P + 16 * s);
        }
        f32x16 acc[4];
#pragma unroll
        for (int hd = 0; hd < 4; ++hd) {
            acc[hd] = f32x16{};
#pragma unroll
            for (int s = 0; s < 4; ++s) acc[hd] = __builtin_amdgcn_mfma_f32_32x32x16_bf16(kf[s], qf[hd][s], acc[hd], 0, 0, 0);
        }
        unsigned gtw = 0u, eqw = 0u;
#pragma unroll
        for (int rg = 0; rg < 16; ++rg) {
            const int cr = att::crow(rg, h2);
            float sv = (__builtin_amdgcn_fmed3f(acc[0][rg], lo4.x, hi4.x) + __builtin_amdgcn_fmed3f(acc[1][rg], lo4.y, hi4.y)) + (__builtin_amdgcn_fmed3f(acc[2][rg], lo4.z, hi4.z) + __builtin_amdgcn_fmed3f(acc[3][rg], lo4.w, hi4.w));
            sv += 0.0f;
            const unsigned ok = okey(sv);
            const bool valid = (32 * kt + cr) <= tq;
            if (LEVEL < 4) {
                const bool match = valid && (LEVEL == 0 || (ok >> ((32 - 8 * LEVEL) & 31)) == pfx);
                if (match) atomicAdd((unsigned*)&hist[r * HROW + ((ok >> (24 - 8 * (LEVEL & 3))) & 255u)], 1u);
            } else {
                const bool gt = valid && (selall || ok > pfx), eq = valid && !selall && ok == pfx;
                gtw |= (gt ? 1u : 0u) << cr; eqw |= (eq ? 1u : 0u) << cr;
            }
        }
        if (LEVEL == 4) {
            gtw |= (unsigned)__shfl_xor((int)gtw, 32); eqw |= (unsigned)__shfl_xor((int)eqw, 32);
            if (h2 == 0) { gtm[r * HROW + kt] = gtw; eqm[r * HROW + kt] = eqw; }
        }
#pragma unroll
        for (int s = 0; s < 4; ++s) kf[s] = kn[s];
    }
}

__device__ __forceinline__ void pick_digit(LAS unsigned char* lds, int tid) {
    LAS unsigned* hist = (LAS unsigned*)(lds + OFF_HIST);
    LAS unsigned* pfxp = (LAS unsigned*)(lds + OFF_PFX);
    LAS int* needp = (LAS int*)(lds + OFF_NEED);
    const int q = tid >> 4, i = tid & 15;
    unsigned c[16]; unsigned cs = 0u;
#pragma unroll
    for (int k = 0; k < 16; ++k) { c[k] = hist[q * HROW + 16 * i + k]; cs += c[k]; }
    unsigned v = cs;
#pragma unroll
    for (int o = 1; o < 16; o <<= 1) { const unsigned t = (unsigned)__shfl_down((int)v, o, 16); if (i + o < 16) v += t; }
    const unsigned above = v - cs;
    const unsigned need = (unsigned)needp[q];
    __syncthreads();
    if (above < need && need <= above + cs) {
        unsigned cum = above; int digit = 0; unsigned nn = need;
        bool done = false;
#pragma unroll
        for (int k = 15; k >= 0; --k) { if (!done) { if (cum + c[k] >= need) { digit = 16 * i + k; nn = need - cum; done = true; } else cum += c[k]; } }
        pfxp[q] = (pfxp[q] << 8) | (unsigned)digit; needp[q] = (int)nn;
    }
#pragma unroll
    for (int k = 0; k < 16; ++k) hist[q * HROW + 16 * i + k] = 0u;
    if (i == 0) hist[q * HROW + 256] = 0u;
    __syncthreads();
}

__device__ __forceinline__ void run_unit(LAS unsigned char* lds, const bf16* y0, const float* aux, unsigned* maskg, int b, int g, int tid_in, int wave, int lane) {
    const int tid = opaque_i(tid_in);
    const int lane_o = opaque_i(lane); const int r = lane_o & 31, h2 = lane_o >> 5, t0 = 32 * g;
    const size_t rowbase = (size_t)b * S;
    LAS unsigned* hist = (LAS unsigned*)(lds + OFF_HIST);
    LAS unsigned* gtm = (LAS unsigned*)(lds + OFF_GT);
    LAS unsigned* eqm = (LAS unsigned*)(lds + OFF_EQ);
    for (int i = tid; i < (3 * 33024) / 4; i += NTHR) ((LAS unsigned*)(lds + OFF_HIST))[i] = 0u;
    if (tid < 32) { ((LAS unsigned*)(lds + OFF_PFX))[tid] = 0u; ((LAS int*)(lds + OFF_NEED))[tid] = 256; }
    bf16x8 qf[4][4];
    {
        const bf16* qp = y0 + (rowbase + t0 + r) * (size_t)Y0P + Y0_IQ + 8 * h2;
#pragma unroll
        for (int hd = 0; hd < 4; ++hd)
#pragma unroll
            for (int s = 0; s < 4; ++s) qf[hd][s] = *(const bf16x8*)(qp + hd * 64 + 16 * s);
    }
    const f32x4 w4 = *(const f32x4*)(aux + (rowbase + t0 + r) * 16 + 8);
    f32x4 lo4, hi4;
#pragma unroll
    for (int hd = 0; hd < 4; ++hd) {
        const float wsc = w4[hd] * 0.0625f;
        lo4[hd] = (w4[hd] >= 0.f) ? 0.f : -INFINITY; hi4[hd] = (w4[hd] >= 0.f) ? INFINITY : 0.f;
#pragma unroll
        for (int s = 0; s < 4; ++s) {
            bf16x8 a = qf[hd][s];
#pragma unroll
            for (int j = 0; j < 8; ++j) a[j] = (short)f2bf(__uint_as_float(((unsigned)(unsigned short)a[j]) << 16) * wsc);
            qf[hd][s] = a;
        }
    }
    const bf16* kbase = y0 + rowbase * (size_t)Y0P + Y0_IK;
    __syncthreads();
    pass<0>(lds, kbase, g, t0, qf, lo4, hi4, wave, r, h2); __syncthreads(); pick_digit(lds, tid);
    pass<1>(lds, kbase, g, t0, qf, lo4, hi4, wave, r, h2); __syncthreads(); pick_digit(lds, tid);
    pass<2>(lds, kbase, g, t0, qf, lo4, hi4, wave, r, h2); __syncthreads(); pick_digit(lds, tid);
    pass<3>(lds, kbase, g, t0, qf, lo4, hi4, wave, r, h2); __syncthreads(); pick_digit(lds, tid);
    pass<4>(lds, kbase, g, t0, qf, lo4, hi4, wave, r, h2); __syncthreads();
    {
        const int q = tid >> 4, i = tid & 15;
        unsigned e[16]; int cs = 0;
#pragma unroll
        for (int k = 0; k < 16; ++k) { e[k] = eqm[q * HROW + 16 * i + k]; cs += __popc(e[k]); }
        int v = cs;
#pragma unroll
        for (int o = 1; o < 16; o <<= 1) { const int t = __shfl_up(v, o, 16); if (i >= o) v += t; }
        int remaining = ((const LAS int*)(lds + OFF_NEED))[q] - (v - cs);
        unsigned outw[16];
#pragma unroll
        for (int k = 0; k < 16; ++k) {
            unsigned take = 0u;
            if (remaining > 0) {
                const int pc = __popc(e[k]);
                if (pc <= remaining) { take = e[k]; remaining -= pc; }
                else { unsigned mm = e[k]; for (int j = 0; j < remaining; ++j) { const unsigned low = mm & (0u - mm); take |= low; mm ^= low; } remaining = 0; }
            }
            outw[k] = gtm[q * HROW + 16 * i + k] | take;
        }
#pragma unroll
        for (int k = 0; k < 16; ++k) gtm[q * HROW + 16 * i + k] = outw[k];
    }
    __syncthreads();
    write_mask_T(gtm, maskg, b, t0, tid);
    __syncthreads();
}
constexpr int NB2 = 480, HROW2 = 481, CAP2 = 256;
constexpr int OFF2_SV = 102400;
static_assert(OFF2_SV + 8 * 4096 <= LDS_CTL_OFF, "dsa stash");
constexpr int OFF2_HIST = 0, OFF2_CAND = 0, OFF2_GT = 65536, OFF2_TB = OFF2_GT + 33024, OFF2_NEED = OFF2_TB + 128, OFF2_CNT = OFF2_NEED + 128, OFF2_FLAG = OFF2_CNT + 128;
static_assert(OFF2_FLAG + 64 <= OFF_SLOT + 100000 && 32 * HROW2 * 4 <= 65536, "dsa LDS map");

__device__ __forceinline__ int bin2(float sv, int zi) {
    const unsigned u = __float_as_uint(sv);
    int c = (int)((u >> 20) & 0x7FFu) - 832;
    c = c < 0 ? 0 : (c > 207 ? 207 : c);
    int b = (u >> 31) ? (207 - c) : (272 + c);
    if (sv == 0.0f) b = 208 + zi;
    return b;
}

__device__ __forceinline__ float fadd_s(float a, float b) { float r; asm("v_add_f32 %0, %1, %2" : "=v"(r) : "v"(a), "v"(b)); return r; }
template <int STAGE>
__device__ __forceinline__ void pass2(LAS unsigned char* lds, const bf16* kbase, int g, int t0, const bf16x8 (&qf)[4][4], const f32x4 lo4, const f32x4 hi4, int wave, int r, int h2) {
    LAS unsigned* hist = (LAS unsigned*)(lds + OFF2_HIST);
    LAS unsigned long long* cand = (LAS unsigned long long*)(lds + OFF2_CAND);
    LAS unsigned* gtm = (LAS unsigned*)(lds + OFF2_GT);
    LAS unsigned* cntp = (LAS unsigned*)(lds + OFF2_CNT);
    const int tq = t0 + r;
    const int tb = (STAGE == 1) ? ((const LAS int*)(lds + OFF2_TB))[r] : 0;
    bf16x8 kf[4], kn[4];
    const bf16* kp = kbase + (size_t)r * Y0P + 8 * h2;
    auto tile = [&](auto which_, const int kt, auto diag_) __attribute__((always_inline)) {
        constexpr bool DIAG = decltype(diag_)::value, WN = decltype(which_)::value;
        f32x16 acc[4];
#pragma unroll
        for (int hd = 0; hd < 4; ++hd) {
            acc[hd] = f32x16{};
#pragma unroll
            for (int s = 0; s < 4; ++s) acc[hd] = __builtin_amdgcn_mfma_f32_32x32x16_bf16(WN ? kn[s] : kf[s], qf[hd][s], acc[hd], 0, 0, 0);
        }
        const int zi = (8191 - 32 * kt) >> 7;
        const int lim = tq - 32 * kt - 4 * h2;
        unsigned gtw = 0u, eqw = 0u;
        float svq[16];
#pragma unroll
        for (int rg = 0; rg < 16; ++rg) {
            const int c0 = att::crow(rg, 0);
            float sv = fadd_s(fadd_s(__builtin_amdgcn_fmed3f(acc[0][rg], lo4.x, hi4.x), __builtin_amdgcn_fmed3f(acc[1][rg], lo4.y, hi4.y)),
                              fadd_s(__builtin_amdgcn_fmed3f(acc[2][rg], lo4.z, hi4.z), __builtin_amdgcn_fmed3f(acc[3][rg], lo4.w, hi4.w)));
            const int b = bin2(sv, zi);
            const bool valid = !DIAG || c0 <= lim;
            if (STAGE == 0) {
                atomicAdd((unsigned*)&hist[r * HROW2 + (valid ? b : NB2)], 1u);
            } else {
                if (valid && b > tb) gtw |= 1u << c0;
                if (valid && b == tb) eqw |= 1u << c0;
                svq[rg] = sv;
            }
        }
        if (STAGE == 1) {
            LAS unsigned char* st = lds + OFF2_SV + wave * 4096 + (r + 32 * h2) * 16;
#pragma unroll
            for (int q = 0; q < 4; ++q) *(LAS f32x4*)(st + q * 1024) = (f32x4){svq[4 * q], svq[4 * q + 1], svq[4 * q + 2], svq[4 * q + 3]};
            unsigned e = eqw;
            while (__any(e != 0u)) {
                if (e != 0u) {
                    const int c = __builtin_ctz(e); e &= e - 1u;
                    float svv = *(const LAS float*)(st + (c >> 3) * 1024 + (c & 3) * 4);
                    svv = fadd_s(svv, 0.0f);
                    const unsigned pos = atomicAdd((unsigned*)&cntp[r], 1u);
                    if (pos < (unsigned)CAP2) cand[r * CAP2 + pos] = ((unsigned long long)okey(svv) << 13) | (unsigned long long)(8191 - (32 * kt + c + 4 * h2));
                }
            }
            gtw <<= 4 * h2;
            { auto rr = __builtin_amdgcn_permlane32_swap(gtw, gtw, false, false); gtw = rr[0] | rr[1]; }
            if (h2 == 0) gtm[r * HROW + kt] = gtw;
        }
    };
#define DSA2_LOADK(dst, kt_) do { _Pragma("unroll") for (int s = 0; s < 4; ++s) dst[s] = *(const bf16x8*)(kp + (size_t)(32 * (kt_)) * Y0P + 16 * s); } while (0)
    int kt = wave;
    if (kt <= g) DSA2_LOADK(kf, kt);
    for (;;) {
        if (kt > g) break;
        if (kt + 8 <= g) DSA2_LOADK(kn, kt + 8);
        if (kt == g) { tile(pg8::BoolC2<false>{}, kt, pg8::BoolC2<true>{}); break; }
        tile(pg8::BoolC2<false>{}, kt, pg8::BoolC2<false>{});
        kt += 8;
        if (kt > g) break;
        if (kt + 8 <= g) DSA2_LOADK(kf, kt + 8);
        if (kt == g) { tile(pg8::BoolC2<true>{}, kt, pg8::BoolC2<true>{}); break; }
        tile(pg8::BoolC2<true>{}, kt, pg8::BoolC2<false>{});
        kt += 8;
    }
#undef DSA2_LOADK
}

__device__ __forceinline__ bool run_unit2(LAS unsigned char* lds, const bf16* y0, const float* aux, unsigned* maskg, int b, int g, int tid_in, int wave, int lane) {
    const int tid = opaque_i(tid_in);
    const int lane_o = opaque_i(lane); const int r = lane_o & 31, h2 = lane_o >> 5, t0 = 32 * g;
    const size_t rowbase = (size_t)b * S;
    LAS unsigned* hist = (LAS unsigned*)(lds + OFF2_HIST);
    LAS unsigned* gtm = (LAS unsigned*)(lds + OFF2_GT);
    for (int i = tid; i < (OFF2_TB) / 4; i += NTHR) ((LAS unsigned*)lds)[i] = 0u;
    if (tid < 32) { ((LAS unsigned*)(lds + OFF2_CNT))[tid] = 0u; }
    if (tid == 0) ((LAS int*)(lds + OFF2_FLAG))[0] = 0;
    bf16x8 qf[4][4];
    {
        const bf16* qp = y0 + (rowbase + t0 + r) * (size_t)Y0P + Y0_IQ + 8 * h2;
#pragma unroll
        for (int hd = 0; hd < 4; ++hd)
#pragma unroll
            for (int s = 0; s < 4; ++s) qf[hd][s] = *(const bf16x8*)(qp + hd * 64 + 16 * s);
    }
    const f32x4 w4 = *(const f32x4*)(aux + (rowbase + t0 + r) * 16 + 8);
    f32x4 lo4, hi4;
#pragma unroll
    for (int hd = 0; hd < 4; ++hd) {
        const float wsc = w4[hd] * 0.0625f;
        lo4[hd] = (w4[hd] >= 0.f) ? 0.f : -INFINITY; hi4[hd] = (w4[hd] >= 0.f) ? INFINITY : 0.f;
#pragma unroll
        for (int s = 0; s < 4; ++s) {
            bf16x8 a = qf[hd][s];
#pragma unroll
            for (int j = 0; j < 8; ++j) a[j] = (short)f2bf(__uint_as_float(((unsigned)(unsigned short)a[j]) << 16) * wsc);
            qf[hd][s] = a;
        }
    }
    const bf16* kbase = y0 + rowbase * (size_t)Y0P + Y0_IK;
    __syncthreads();
    pass2<0>(lds, kbase, g, t0, qf, lo4, hi4, wave, r, h2);
    __syncthreads();
    {
        const int q = tid >> 4, i = tid & 15;
        unsigned c[30]; unsigned cs = 0u;
#pragma unroll
        for (int k = 0; k < 30; ++k) { c[k] = hist[q * HROW2 + 30 * i + k]; cs += c[k]; }
        unsigned v = cs;
#pragma unroll
        for (int o = 1; o < 16; o <<= 1) { const unsigned t = (unsigned)__shfl_down((int)v, o, 16); if (i + o < 16) v += t; }
        const unsigned above = v - cs;
        if (i == 0) { const bool selall = (t0 + q) < 256; if (selall || v < 256u) { ((LAS int*)(lds + OFF2_TB))[q] = -1; ((LAS int*)(lds + OFF2_NEED))[q] = 0; } }
        if (!((t0 + q) < 256) && above < 256u && 256u <= above + cs) {
            unsigned cum = above; bool done = false;
#pragma unroll
            for (int k = 29; k >= 0; --k) { if (!done) { if (cum + c[k] >= 256u) { ((LAS int*)(lds + OFF2_TB))[q] = 30 * i + k; ((LAS int*)(lds + OFF2_NEED))[q] = (int)(256u - cum);
                        if (c[k] > (unsigned)CAP2) ((LAS int*)(lds + OFF2_FLAG))[0] = 1; done = true; } else cum += c[k]; } }
        }
    }
    __syncthreads();
    if (((const LAS int*)(lds + OFF2_FLAG))[0] != 0) { __syncthreads(); return false; }
    for (int i = tid; i < 65536 / 4; i += NTHR) ((LAS unsigned*)lds)[i] = 0u;
    __syncthreads();
    pass2<1>(lds, kbase, g, t0, qf, lo4, hi4, wave, r, h2);
    __syncthreads();
    {
        const int q = tid >> 4, i = tid & 15;
        const LAS unsigned long long* cq = (const LAS unsigned long long*)(lds + OFF2_CAND) + q * CAP2;
        const int n = (int)((const LAS unsigned*)(lds + OFF2_CNT))[q], need = ((const LAS int*)(lds + OFF2_NEED))[q];
        for (int a_ = i; a_ < n; a_ += 16) {
            const unsigned long long mine = cq[a_];
            int rank = 0;
            const int n8 = (n + 7) & ~7;
            for (int j = 0; j < n8; j += 8) {
                unsigned long long cj[8];
#pragma unroll
                for (int k = 0; k < 8; ++k) cj[k] = cq[j + k];
#pragma unroll
                for (int k = 0; k < 8; ++k) rank += (cj[k] > mine) ? 1 : 0;
            }
            if (rank < need) { const int idx = 8191 - (int)(mine & 8191ull); atomicOr((unsigned*)&gtm[q * HROW + (idx >> 5)], 1u << (idx & 31)); }
        }
    }
    __syncthreads();
    write_mask_T(gtm, maskg, b, t0, tid);
    __syncthreads();
    return true;
}
}

struct Args {
    const float* in[22];
    float* out;
    unsigned char* ws;
    int ph_lo, ph_hi;
};

struct ColMap {
    int nseg; int d0[10], s0[10], len[10];
    __device__ __forceinline__ int src(int n) const {
        int r = -1;
#pragma unroll
        for (int i = 0; i < 10; ++i) if (i < nseg && n >= d0[i] && n < d0[i] + len[i]) r = s0[i] + (n - d0[i]);
        return r;
    }
};
__device__ __forceinline__ void conv_weight(const float* W, int K, int Nsrc, bf16* Bt, int Ndst, const float* gain, const ColMap& cm,
                                            LAS float* scr, int gw, int ngw, int lane) {
    const int nblk = Ndst / 32, kblk = K / 64;
    for (int it = gw; it < nblk * kblk; it += ngw) {
        const int kb = it / nblk, nb = it % nblk, k0 = kb * 64, n0 = nb * 32;
        const int sc = cm.src(n0 + (lane & 31));
#pragma unroll 8
        for (int i = 0; i < 32; ++i) {
            const int kk = 2 * i + (lane >> 5);
            float v = 0.f;
            if (sc >= 0) v = W[(size_t)(k0 + kk) * Nsrc + sc] * (gain ? gain[k0 + kk] : 1.0f);
            scr[kk * 33 + (lane & 31)] = v;
        }
        WAVE_LDS_SYNC();
        const int c = lane & 7;
#pragma unroll
        for (int j = 0; j < 4; ++j) {
            const int n = (lane >> 3) + 8 * j;
            const LAS float* s = scr + (8 * c) * 33 + n;
            u32x4 o; o.x = pk2(s[0 * 33], s[1 * 33]); o.y = pk2(s[2 * 33], s[3 * 33]); o.z = pk2(s[4 * 33], s[5 * 33]); o.w = pk2(s[6 * 33], s[7 * 33]);
            *(u32x4*)(Bt + (size_t)(n0 + n) * K + k0 + 8 * c) = o;
        }
        WAVE_LDS_SYNC();
    }
}

template <int PH>
__device__ __forceinline__ void mk_body(const Args& a) {
    extern __shared__ __attribute__((aligned(16))) unsigned char lds_raw[];
    LAS unsigned char* lds = (LAS unsigned char*)lds_raw;
    const int wave = __builtin_amdgcn_readfirstlane((int)threadIdx.x >> 6);
#define LANE_TID() const int lane = lane_id_v(), tid = wave * 64 + lane; (void)tid; (void)lane
    const int G = gridDim.x, bid = blockIdx.x;
    const int gw = bid * 8 + wave, ngw = G * 8;
    unsigned char* ws = a.ws;
    const float* x_in = a.in[0];
    float* xres = a.out;
#define Wt_in0 ((bf16*)(ws + WS_WIN0))
#define Wt_out0 ((bf16*)(ws + WS_WOUT0))
#define Wt_gu0 ((bf16*)(ws + WS_WGU0))
#define Wt_dn0 ((bf16*)(ws + WS_WDN0))
#define Wt_in1 ((bf16*)(ws + WS_WIN1))
#define Wt_uq ((bf16*)(ws + WS_WUQ))
#define Wt_ukv ((bf16*)(ws + WS_WUKV))
#define Wt_out1 ((bf16*)(ws + WS_WOUT1))
#define Wt_gu1 ((bf16*)(ws + WS_WGU1))
#define Wt_dn1 ((bf16*)(ws + WS_WDN1))
#define rope_cos ((float*)(ws + WS_ROPE))
#define rope_sin (((float*)(ws + WS_ROPE) + S * 16))
#define bucket_tab ((int*)(ws + WS_TAB))
#define maskg ((unsigned*)(ws + WS_MASK))
#define sqa ((float*)(ws + WS_SQA))
#define sqb ((float*)(ws + WS_SQB))
#define aux ((float*)(ws + WS_AUX))
#define lcum ((float*)(ws + WS_LC))
#define ssq ((float*)(ws + WS_SSQ))
#define krope ((bf16*)(ws + WS_KR))
#define xb ((bf16*)(ws + WS_XB))
#define mixed ((bf16*)(ws + WS_MIX))
#define y0 ((bf16*)(ws + WS_BIG))
#define hidden ((bf16*)(ws + WS_BIG))
#define y1 ((bf16*)(ws + WS_Y1))
#define mq ((bf16*)(ws + WS_MQ))
#define mkv ((bf16*)(ws + WS_MKV))
    const float* t5 = a.in[17];
    unsigned* ctl = (unsigned*)(ws + WS_CTL);
    const int lo = a.ph_lo, hi = a.ph_hi;
    XcdBarrier bar; bar.bar = (unsigned*)(ws + WS_CTL) + CW_BAR; bar.x = 0; bar.st = nullptr; bar.wave = wave;
    if (PH < 0) {
        volatile LAS unsigned* stw = (volatile LAS unsigned*)(lds + LDS_CTL_OFF);
        { LANE_TID(); if (tid < 16) stw[tid] = 0u; }
        __syncthreads();
        bar = xcd_barrier_post((unsigned*)(ws + WS_CTL) + CW_BAR, stw, wave);
    }
#define SEAM() do { if (PH < 0) xcd_barrier(bar); } while (0)
#define IN(k) (PH < 0 ? (lo <= (k) && (k) < hi) : (PH == (k)))

    if (IN(0)) {
        LANE_TID();
        LAS float* scr = (LAS float*)lds + wave * (64 * 33);
        {
            ColMap cm; cm.nseg = 10;
            const int d0[10] = {Y0_FQ, Y0_FK, Y0_FV, Y0_DQ, Y0_DK, Y0_DV, Y0_IQ, Y0_IK, Y0_FF, Y0_IW};
            const int s0[10] = {0, 512, 1024, 1544, 2056, 2568, 3080, 3336, 1536, 3400};
            const int ln[10] = {512, 512, 512, 512, 512, 512, 256, 64, 8, 4};
#pragma unroll
            for (int i = 0; i < 10; ++i) { cm.d0[i] = d0[i]; cm.s0[i] = s0[i]; cm.len[i] = ln[i]; }
            conv_weight(a.in[3], D, EVEN_IN, Wt_in0, Y0P, a.in[1], cm, scr, gw, ngw, lane);
        }
        {
            ColMap cm; cm.nseg = 1; cm.d0[0] = 0; cm.s0[0] = 0;
#pragma unroll
            for (int i = 1; i < 10; ++i) { cm.d0[i] = 0; cm.s0[i] = 0; cm.len[i] = 0; }
            cm.len[0] = D;
            conv_weight(a.in[5], D, D, Wt_out0, D, nullptr, cm, scr, gw, ngw, lane);
            conv_weight(a.in[16], D, D, Wt_out1, D, nullptr, cm, scr, gw, ngw, lane);
            conv_weight(a.in[20], FFH, D, Wt_dn0, D, nullptr, cm, scr, gw, ngw, lane);
            conv_weight(a.in[20] + (size_t)FFH * D, FFH, D, Wt_dn1, D, nullptr, cm, scr, gw, ngw, lane);
            cm.len[0] = ODD_IN;
            conv_weight(a.in[6], D, ODD_IN, Wt_in1, Y1P, a.in[1] + D, cm, scr, gw, ngw, lane);
            cm.len[0] = 768;
            conv_weight(a.in[13], 256, 768, Wt_uq, 768, a.in[12], cm, scr, gw, ngw, lane);
            cm.len[0] = 1024;
            conv_weight(a.in[15], 128, 1024, Wt_ukv, 1024, a.in[14], cm, scr, gw, ngw, lane);
        }
        {
            const int tiles_per = (D / 64) * 4;
            for (int it = gw; it < 88 * tiles_per; it += ngw) {
                const int slab = it / tiles_per, tt = it % tiles_per;
                const int layer = slab / 44, j = (slab % 44) >> 1, up = slab & 1;
                const float* W = (up ? a.in[19] : a.in[18]) + (size_t)layer * D * FFH;
                bf16* Bt = (layer ? Wt_gu1 : Wt_gu0) + (size_t)(256 * j + 128 * up) * D;
                const float* gain = a.in[2] + layer * D;
                const int kb = tt / 4, nb = tt % 4, k0 = kb * 64, n0 = nb * 32;
                const int sc = 128 * j + n0 + (lane & 31);
#pragma unroll 8
                for (int i = 0; i < 32; ++i) { const int kk = 2 * i + (lane >> 5); scr[kk * 33 + (lane & 31)] = W[(size_t)(k0 + kk) * FFH + sc] * gain[k0 + kk]; }
                WAVE_LDS_SYNC();
                const int c = lane & 7;
#pragma unroll
                for (int jj = 0; jj < 4; ++jj) {
                    const int n = (lane >> 3) + 8 * jj;
                    const LAS float* sp = scr + (8 * c) * 33 + n;
                    u32x4 ov; ov.x = pk2(sp[0 * 33], sp[1 * 33]); ov.y = pk2(sp[2 * 33], sp[3 * 33]); ov.z = pk2(sp[4 * 33], sp[5 * 33]); ov.w = pk2(sp[6 * 33], sp[7 * 33]);
                    *(u32x4*)(Bt + (size_t)(n0 + n) * D + k0 + 8 * c) = ov;
                }
                WAVE_LDS_SYNC();
            }
        }
        for (int m0 = gw * 4; m0 < M; m0 += ngw * 4) {
            f32x4 v[4][4];
#pragma unroll
            for (int rr_ = 0; rr_ < 4; ++rr_)
#pragma unroll
                for (int j = 0; j < 4; ++j) v[rr_][j] = ((const f32x4*)(x_in + (size_t)(m0 + rr_) * D) + lane)[64 * j];
#pragma unroll
            for (int rr_ = 0; rr_ < 4; ++rr_) {
                unsigned long long* o8 = (unsigned long long*)(xb + (size_t)(m0 + rr_) * D) + lane;
                float s = 0.f;
#pragma unroll
                for (int j = 0; j < 4; ++j) {
                    const f32x4 w_ = v[rr_][j];
                    s += (w_.x * w_.x + w_.y * w_.y) + (w_.z * w_.z + w_.w * w_.w);
                    o8[64 * j] = (unsigned long long)pk2(w_.x, w_.y) | ((unsigned long long)pk2(w_.z, w_.w) << 32);
                }
                s = wave_sum(s);
                if (lane < 16) ssq[(size_t)(m0 + rr_) * 16 + lane] = (lane == 0) ? s : 0.f;
            }
        }
        for (int i = bid * NTHR + tid; i < S * 16; i += G * NTHR) {
            const int pos = i >> 4, j = i & 15;
            const float inv = powf(10000.0f, -(float)(2 * j) / 32.0f);
            const float ang = (float)pos * inv;
            rope_cos[i] = cosf(ang); rope_sin[i] = sinf(ang);
        }
        if (bid == 0 && tid < 128) bucket_tab[tid] = t5_bucket_dev(tid);
    }

    SEAM();
    if (IN(1)) {
        pg8::Gemm g{xb, Wt_in0, M, Y0P, D, D, D}; pg8::StaticOrder So; So.init(M, Y0P, G, bid);
        pg8::EpiScale E{y0, Y0P, ssq, aux, 13, nullptr, -1, nullptr, -1};
        pg8::gemm_phase<pg8::EpiScale, pg8::StaticOrder, true, true>(lds, g, So, E, wave);
    }
    SEAM();
    if (IN(2)) {
        LANE_TID();
        for (int seq = bid; seq < NB * 8; seq += G) {
            const int b = seq >> 3, h = seq & 7;
            const float bf = a.in[4][h];
            const size_t r0 = (size_t)b * S + tid * 16;
            float v[16]; float run = 0.f;
#pragma unroll
            for (int i = 0; i < 16; ++i) {
                const float z = aux[(r0 + i) * 16 + h] + bf;
                run += fminf(z, 0.f) - log1pf(expf(-fabsf(z)));
                v[i] = run;
            }
            float incl = run;
#pragma unroll
            for (int o = 1; o < 64; o <<= 1) { const float t = __shfl_up(incl, o); if (lane >= o) incl += t; }
            LAS float* wtot = (LAS float*)lds;
            if (lane == 63) wtot[wave] = incl;
            __syncthreads();
            float off = incl - run;
            for (int w_ = 0; w_ < wave; ++w_) off += wtot[w_];
#pragma unroll
            for (int i = 0; i < 16; ++i) lcum[(r0 + i) * 8 + h] = off + v[i];
            __syncthreads();
        }
        for (int k0 = bid * 8; k0 < M / 32; k0 += ngw) {
            const int blk = k0 + wave;
            float mx2 = 0.f;
            if (blk < M / 32) {
#pragma unroll 8
                for (int i = 0; i < 32; ++i) {
                    const u32x4 v = *(const u32x4*)(y0 + (size_t)(blk * 32 + i) * Y0P + Y0_FK + 8 * lane);
                    float s = 0.f;
#pragma unroll
                    for (int j = 0; j < 4; ++j) { const float lo_ = __uint_as_float(v[j] << 16), hi_ = __uint_as_float(v[j] & 0xffff0000u); s = fmaf(lo_, lo_, s); s = fmaf(hi_, hi_, s); }
                    s += __shfl_xor(s, 1); s += __shfl_xor(s, 2); s += __shfl_xor(s, 4);
                    mx2 = fmaxf(mx2, s);
                }
            }
            LAS float* wmx = (LAS float*)lds + 64;
            __syncthreads();
            if ((lane & 7) == 0) wmx[wave * 8 + (lane >> 3)] = mx2;
            __syncthreads();
            if (wave == 0 && lane < 8) {
                float mm = 0.f;
#pragma unroll
                for (int w_ = 0; w_ < 8; ++w_) mm = fmaxf(mm, wmx[w_ * 8 + lane]);
                atomicMax(ctl + CW_KMAX + ((k0 * 32) / S) * 8 + lane, __float_as_uint(mm));
            }
        }
    }

    SEAM();
    if (IN(3)) {
        LANE_TID();
        const int lane_o = opaque_i(lane); const int rr = lane_o & 31, hh = lane_o >> 5;
        att::QPre qp{nullptr, 0u, false};
        for (;;) {
            const int u = att::next_unit_pre(qp, ctl + CW_Q + 0 * 512, 256, lds, att::OFF_MISC, wave);
            if (u < 0) break;
            const int b = u >> 8, h = 2 * ((u >> 6) & 3) + ((u >> 4) & 1), qb = ((u >> 5) & 1) ? 15 - (u & 15) : 31 - (u & 15);
            att::Tens T{};
            T.Q = y0 + Y0_FQ + h * 64; T.ldq = Y0P; T.K = y0 + Y0_FK + h * 64; T.ldk = Y0P; T.V = y0 + Y0_FV + h * 64; T.ldv = Y0P;
            T.lc = lcum + h; T.scale2 = 0.125f * att::LOG2E;
            T.kmaxn = sqrtf(__uint_as_float(__hip_atomic_load(ctl + CW_KMAX + b * 8 + h, __ATOMIC_RELAXED, __HIP_MEMORY_SCOPE_AGENT)));
            att::f32x16 o[2]; float l;
            att::attn_pass<att::AM_FOX, 64, 64>(lds, T, (size_t)b * S, qb * 256, o, l, wave, &qp);
            att::store_o<64>(mixed + ((size_t)b * S + qb * 256 + wave * 32 + rr) * D + h * 64, o, l, hh);
        }
    }
    if (IN(4)) {
        LANE_TID();
        for (;;) {
            const int u = att::next_unit(ctl + CW_Q + 4 * 512, 256, lds, dsa::OFF_SLOT, wave);
            if (u < 0) break;
            const int b = u >> 8, g = 255 - (u & 255);
            if (!dsa::run_unit2(lds, y0, aux, maskg, b, g, tid, wave, lane))
                dsa::run_unit(lds, y0, aux, maskg, b, g, tid, wave, lane);
        }
    }
    SEAM();
    if (IN(19)) {
        att::QPre qp{nullptr, 0u, false};
        for (;;) {
            const int u = att::next_unit_pre(qp, ctl + CW_Q + 1 * 512, 256, lds, att::OFF_MISC, wave);
            if (u < 0) break;
            const int b = u >> 8, h = (u >> 5) & 7, qb = 31 - (u & 31);
            { const int t_ = wave * 64 + lane_id_v();
              if (t_ <= 128) ((LAS float*)(lds + att::OFF_LUT))[t_] = (t_ < 128) ? (t5[bucket_tab[t_] * 8 + h] - t5[31 * 8 + h]) * att::LOG2E : 0.f;
              if (t_ >= 192 && t_ < 256) { const int e_ = (t_ - 192) >> 2, c_ = t_ & 3; ((LAS float*)(lds + att::OFF_LUT + 768))[t_ - 192] = ((e_ >> c_) & 1) ? 0.f : -INFINITY; } }
            att::Tens T{};
            T.Q = y0 + Y0_DQ + h * 64; T.ldq = Y0P; T.K = y0 + Y0_DK + h * 64; T.ldk = Y0P; T.V = y0 + Y0_DV + h * 64; T.ldv = Y0P;
            T.mask = maskg; T.scale2 = 0.125f * att::LOG2E;
            att::f32x16 o[2]; float l;
            att::attn_pass<att::AM_DSA, 64, 64>(lds, T, (size_t)b * S, qb * 256, o, l, wave, &qp);
            const int lane_o = lane_id_v(); const int rr = lane_o & 31, hh = lane_o >> 5;
            att::store_o<64>(mixed + ((size_t)b * S + qb * 256 + wave * 32 + rr) * D + 512 + h * 64, o, l, hh);
        }
    }
    SEAM();
    if (IN(5)) {
        pg8::Gemm g{mixed, Wt_out0, M, D, D, D, D}; pg8::StaticOrder So; So.init(M, D, G, bid);
        pg8::EpiResid<true, false> E{nullptr, nullptr, xb, ssq};
        pg8::gemm_phase<pg8::EpiResid<true, false>, pg8::StaticOrder, true, true>(lds, g, So, E, wave);
    }

    SEAM();

    if (IN(7)) {
        pg8::Gemm g{xb, Wt_gu0, M, 2 * FFH, D, D, D}; pg8::StaticOrder So; So.init(M, 2 * FFH, G, bid);
        pg8::EpiGU E{hidden, FFH, ssq};
        pg8::gemm_phase<pg8::EpiGU, pg8::StaticOrder, true, true>(lds, g, So, E, wave);
    }
    SEAM();
    if (IN(8)) {
        pg8::Gemm g{hidden, Wt_dn0, M, D, FFH, FFH, FFH}; pg8::StaticOrder So; So.init(M, D, G, bid);
        pg8::EpiResid<true, false> E{nullptr, nullptr, xb, ssq};
        pg8::gemm_phase<pg8::EpiResid<true, false>, pg8::StaticOrder, true, true>(lds, g, So, E, wave);
    }
    SEAM();

    if (IN(10)) {
        pg8::Gemm g{xb, Wt_in1, M, Y1P, D, D, D}; pg8::StaticOrder So; So.init(M, Y1P, G, bid);
        pg8::EpiScale E{y1, Y1P, ssq, nullptr, -1, sqa, 6, sqb, 7};
        pg8::gemm_phase<pg8::EpiScale, pg8::StaticOrder, true, true>(lds, g, So, E, wave);
    }

    SEAM();
    if (IN(11)) {
        LANE_TID();
        {
            pg8::Gemm g{y1 + Y1_MCQ, Wt_uq, M, MQP, 256, Y1P, 256}; pg8::StaticOrder So; So.init(M, MQP, G, bid);
            pg8::EpiMkv E{mq, MQP, sqa, 1.0f / 256.0f};
            pg8::gemm_phase<pg8::EpiMkv, pg8::StaticOrder, true, true>(lds, g, So, E, wave);
        }
        {
            pg8::Gemm g{y1 + Y1_MCKV, Wt_ukv, M, MKVP, 128, Y1P, 128}; pg8::StaticOrder So; So.init(M, MKVP, G, bid);
            pg8::EpiMkv E{mkv, MKVP, sqb, 1.0f / 128.0f};
            pg8::gemm_phase<pg8::EpiMkv, pg8::StaticOrder, true, true>(lds, g, So, E, wave);
        }
        for (int it = bid * NTHR + tid; it < M * 16; it += G * NTHR) {
            const int m = it >> 4, i = it & 15, t = m & (S - 1);
            const float x1 = bf2f(y1[(size_t)m * Y1P + Y1_MKR + i]), x2 = bf2f(y1[(size_t)m * Y1P + Y1_MKR + 16 + i]);
            const float cs = rope_cos[t * 16 + i], sn = rope_sin[t * 16 + i];
            krope[(size_t)m * 32 + i] = f2bf(x1 * cs - x2 * sn);
            krope[(size_t)m * 32 + 16 + i] = f2bf(x2 * cs + x1 * sn);
        }
    }
    SEAM();
    if (IN(12)) {
        LANE_TID();
        att::QPre qp{nullptr, 0u, false};
        float lam;
        {
            float s1 = 0.f, s2 = 0.f;
            for (int i = 0; i < 64; ++i) { s1 += a.in[7][i] * a.in[8][i]; s2 += a.in[9][i] * a.in[10][i]; }
            lam = expf(s1) - expf(s2) + LAMBDA_INIT;
        }
        for (;;) {
            const int u = att::next_unit_pre(qp, ctl + CW_Q + 2 * 512, 128, lds, att::OFF_MISC, wave);
            if (u < 0) break;
            const int b = u >> 7, h = (u >> 5) & 3, qb = 31 - (u & 31);
            att::f32x16 oa[4];
#pragma unroll 1
            for (int mp = 0; mp < 2; ++mp) {
                const int mh = 2 * h + mp;
                { const int t_ = wave * 64 + lane_id_v(); if (t_ <= 128) ((LAS float*)(lds + att::OFF_LUT))[t_] = (t_ < 128) ? (t5[bucket_tab[t_] * 8 + mh] - t5[31 * 8 + mh]) * att::LOG2E : 0.f; }
                att::Tens T{};
                T.Q = y1 + Y1_CQ + mh * 64; T.ldq = Y1P; T.K = y1 + Y1_CK + mh * 64; T.ldk = Y1P; T.V = y1 + Y1_CV + h * 128; T.ldv = Y1P;
                T.scale2 = 0.125f * att::LOG2E;
                float l;
                att::attn_pass<att::AM_DIFF, 64, 128>(lds, T, (size_t)b * S, qb * 256, oa, l, wave);
                const float il = 1.0f / l;
                const int lane_s = lane_id_v();
                bf16* stash = mixed + ((size_t)b * S + qb * 256 + wave * 32 + (lane_s & 31)) * D + h * 128 + 8 * (lane_s >> 5);
                if (mp == 0) {
#pragma unroll
                    for (int db = 0; db < 4; ++db)
#pragma unroll
                        for (int gp = 0; gp < 2; ++gp) { u32x2 a_, b_;
                            a_.x = pg8::cvt_pk_bf16(oa[db][8 * gp] * il, oa[db][8 * gp + 1] * il); a_.y = pg8::cvt_pk_bf16(oa[db][8 * gp + 2] * il, oa[db][8 * gp + 3] * il);
                            b_.x = pg8::cvt_pk_bf16(oa[db][8 * gp + 4] * il, oa[db][8 * gp + 5] * il); b_.y = pg8::cvt_pk_bf16(oa[db][8 * gp + 6] * il, oa[db][8 * gp + 7] * il);
                            att::swap_pair(a_, b_);
                            const u32x4 w_ = {a_.x, a_.y, b_.x, b_.y}; *(u32x4*)(stash + 32 * db + 16 * gp) = w_; }
                } else {
                    const float c2 = lam * il;
#pragma unroll
                    for (int db = 0; db < 4; ++db)
#pragma unroll
                        for (int gp = 0; gp < 2; ++gp) { const u32x4 w_ = *(const u32x4*)(stash + 32 * db + 16 * gp);
                            u32x2 a_ = {w_.x, w_.y}, b_ = {w_.z, w_.w};
                            att::swap_pair(a_, b_);
                            const float v[8] = {__uint_as_float(a_.x << 16), __uint_as_float(a_.x & 0xffff0000u), __uint_as_float(a_.y << 16), __uint_as_float(a_.y & 0xffff0000u),
                                                __uint_as_float(b_.x << 16), __uint_as_float(b_.x & 0xffff0000u), __uint_as_float(b_.y << 16), __uint_as_float(b_.y & 0xffff0000u)};
#pragma unroll
                            for (int i = 0; i < 8; ++i) oa[db][8 * gp + i] = v[i] - oa[db][8 * gp + i] * c2; }
                }
            }
            const int lane_o = lane_id_v(); const int rr = lane_o & 31, hh = lane_o >> 5;
            float ss = 0.f;
#pragma unroll
            for (int db = 0; db < 4; ++db)
#pragma unroll
                for (int rg = 0; rg < 16; ++rg) ss += oa[db][rg] * oa[db][rg];
            ss += __shfl_xor(ss, 32);
            const float rn = (1.0f / sqrtf(ss * (1.0f / 128.0f) + RMS_EPS)) * (1.0f - LAMBDA_INIT);
            bf16* orow = mixed + ((size_t)b * S + qb * 256 + wave * 32 + rr) * D + h * 128;
#pragma unroll
            for (int db = 0; db < 4; ++db)
#pragma unroll
                for (int gp = 0; gp < 2; ++gp) {
                    const int d0 = 32 * db + 16 * gp + 4 * hh;
                    const f32x4 g0 = *(const f32x4*)(a.in[11] + d0), g1 = *(const f32x4*)(a.in[11] + d0 + 8);
                    u32x2 a_, b_;
                    a_.x = pg8::cvt_pk_bf16(oa[db][8 * gp + 0] * rn * g0.x, oa[db][8 * gp + 1] * rn * g0.y); a_.y = pg8::cvt_pk_bf16(oa[db][8 * gp + 2] * rn * g0.z, oa[db][8 * gp + 3] * rn * g0.w);
                    b_.x = pg8::cvt_pk_bf16(oa[db][8 * gp + 4] * rn * g1.x, oa[db][8 * gp + 5] * rn * g1.y); b_.y = pg8::cvt_pk_bf16(oa[db][8 * gp + 6] * rn * g1.z, oa[db][8 * gp + 7] * rn * g1.w);
                    att::swap_pair(a_, b_);
                    const u32x4 w = {a_.x, a_.y, b_.x, b_.y};
                    *(u32x4*)(orow + 32 * db + 16 * gp + 8 * hh) = w;
                }
        }
    }
    if (IN(13)) {
        LANE_TID();
        const int lane_o = opaque_i(lane); const int rr = lane_o & 31, hh = lane_o >> 5;
        att::QPre qp{nullptr, 0u, false};
        for (;;) {
            const int u = att::next_unit_pre(qp, ctl + CW_Q + 3 * 512, 256, lds, att::OFF_MISC, wave);
            if (u < 0) break;
            const int b = u >> 8, h = (u >> 5) & 7, qb = 31 - (u & 31);
            att::Tens T{};
            T.Q = mq + h * 96; T.ldq = MQP; T.K = mkv + h * 128; T.ldk = MKVP; T.K2 = krope; T.ldk2 = 32; T.rcos = rope_cos; T.rsin = rope_sin; T.V = mkv + h * 128 + 64; T.ldv = MKVP;
            T.scale2 = 0.10206207261596575f * att::LOG2E;
            att::f32x16 o[2]; float l;
            att::attn_pass<att::AM_MLA, 96, 64>(lds, T, (size_t)b * S, qb * 256, o, l, wave, &qp);
            att::store_o<64>(mixed + ((size_t)b * S + qb * 256 + wave * 32 + rr) * D + 512 + h * 64, o, l, hh);
        }
    }
    SEAM();
    if (IN(14)) {
        pg8::Gemm g{mixed, Wt_out1, M, D, D, D, D}; pg8::StaticOrder So; So.init(M, D, G, bid);
        pg8::EpiResid<true, false> E{nullptr, nullptr, xb, ssq};
        pg8::gemm_phase<pg8::EpiResid<true, false>, pg8::StaticOrder, true, true>(lds, g, So, E, wave);
    }
    SEAM();
    if (IN(16)) {
        pg8::Gemm g{xb, Wt_gu1, M, 2 * FFH, D, D, D}; pg8::StaticOrder So; So.init(M, 2 * FFH, G, bid);
        pg8::EpiGU E{hidden, FFH, ssq};
        pg8::gemm_phase<pg8::EpiGU, pg8::StaticOrder, true, true>(lds, g, So, E, wave);
    }
    SEAM();
    if (IN(17)) {
        pg8::Gemm g{hidden, Wt_dn1, M, D, FFH, FFH, FFH}; pg8::StaticOrder So; So.init(M, D, G, bid);
        pg8::EpiResid<true, false> E{nullptr, nullptr, xb, ssq};
        pg8::gemm_phase<pg8::EpiResid<true, false>, pg8::StaticOrder, true, true>(lds, g, So, E, wave);
    }
    SEAM();

    if (IN(18)) {
        const float* fg = a.in[21];
        const int lane = lane_id_v();
        f32x4 gv[4];
#pragma unroll
        for (int j = 0; j < 2; ++j) { gv[2 * j] = *(const f32x4*)(fg + 512 * j + 8 * lane); gv[2 * j + 1] = *(const f32x4*)(fg + 512 * j + 8 * lane + 4); }
        for (int m0 = gw * 4; m0 < M; m0 += ngw * 4) {
            u32x4 v[4][2]; float rsv[4];
#pragma unroll
            for (int rr_ = 0; rr_ < 4; ++rr_) {
                v[rr_][0] = *(const u32x4*)(xb + (size_t)(m0 + rr_) * D + 8 * lane); v[rr_][1] = *(const u32x4*)(xb + (size_t)(m0 + rr_) * D + 512 + 8 * lane);
                rsv[rr_] = pg8::row_scale16(ssq, m0 + rr_, 1.0f / 1024.0f);
            }
#pragma unroll
            for (int rr_ = 0; rr_ < 4; ++rr_) {
                float* orow = xres + (size_t)(m0 + rr_) * D;
                const float rs = rsv[rr_];
#pragma unroll
                for (int j = 0; j < 2; ++j) {
                    const u32x4 w = v[rr_][j];
                    const f32x4 lo_ = {__uint_as_float(w.x << 16), __uint_as_float(w.x & 0xffff0000u), __uint_as_float(w.y << 16), __uint_as_float(w.y & 0xffff0000u)};
                    const f32x4 hi_ = {__uint_as_float(w.z << 16), __uint_as_float(w.z & 0xffff0000u), __uint_as_float(w.w << 16), __uint_as_float(w.w & 0xffff0000u)};
                    *(f32x4*)(orow + 512 * j + 8 * lane) = lo_ * rs * gv[2 * j];
                    *(f32x4*)(orow + 512 * j + 8 * lane + 4) = hi_ * rs * gv[2 * j + 1];
                }
            }
        }
    }
#undef IN
#undef SEAM
#undef Wt_in0
#undef Wt_out0
#undef Wt_gu0
#undef Wt_dn0
#undef Wt_in1
#undef Wt_uq
#undef Wt_ukv
#undef Wt_out1
#undef Wt_gu1
#undef Wt_dn1
#undef rope_cos
#undef rope_sin
#undef bucket_tab
#undef maskg
#undef sqa
#undef sqb
#undef aux
#undef lcum
#undef ssq
#undef krope
#undef xb
#undef mixed
#undef y0
#undef hidden
#undef y1
#undef mq
#undef mkv
}
template <int PH>
__global__ void __launch_bounds__(NTHR, 2) mk_phase(Args a) { mk_body<PH>(a); }

constexpr int N_PHASES = 20;

extern "C" void kernel_launch(void* const* d_in, const int* in_sizes, int n_in, void* d_out, int out_size, void* d_ws, size_t ws_size, hipStream_t stream) {
    static int grid = 0;
    if (grid == 0) {
        if (n_in != 22 || out_size != M * D || ws_size < WS_END) { fprintf(stderr, "kernel_launch: unexpected sizes n_in %d out %d ws %zu\n", n_in, out_size, ws_size); grid = -1; return; }
        int dev = 0, cus = 0, per_cu = 0;
        if (hipGetDevice(&dev) != hipSuccess || hipDeviceGetAttribute(&cus, hipDeviceAttributeMultiprocessorCount, dev) != hipSuccess) { grid = -1; return; }
        if (hipFuncSetAttribute((const void*)mk_phase<-1>, hipFuncAttributeMaxDynamicSharedMemorySize, LDS_BYTES) != hipSuccess) { grid = -1; return; }
        if (hipOccupancyMaxActiveBlocksPerMultiprocessor(&per_cu, (const void*)mk_phase<-1>, NTHR, LDS_BYTES) != hipSuccess || per_cu < 1) { fprintf(stderr, "kernel_launch: occupancy query says %d\n", per_cu); (void)hipGetLastError(); grid = -1; return; }
        grid = cus;
    }
    if (grid < 0) return;
    (void)hipMemsetAsync((char*)d_ws + WS_CTL, 0, 1 * MiB, stream);
    Args a{};
    for (int i = 0; i < 22; ++i) a.in[i] = (const float*)d_in[i];
    a.out = (float*)d_out; a.ws = (unsigned char*)d_ws;
    a.ph_lo = 0; a.ph_hi = N_PHASES;
    hipLaunchKernelGGL(mk_phase<-1>, dim3(grid), dim3(NTHR), LDS_BYTES, stream, a);
}
```

```cpp
#include <hip/hip_runtime.h>
#include <stdint.h>
#include <stdio.h>

typedef unsigned short bf16;
typedef float f32x4 __attribute__((ext_vector_type(4)));
typedef unsigned u32x4 __attribute__((ext_vector_type(4)));
typedef unsigned u32x2 __attribute__((ext_vector_type(2)));
#define LAS __attribute__((address_space(3)))

constexpr int NB = 8, S = 8192, D = 1024, M = NB * S;
constexpr int HD = 64;
constexpr int FFH = 2816;
constexpr int EVEN_IN = 3404, ODD_IN = 1952;
constexpr int Y0P = 3584;
constexpr int Y0_FQ = 0, Y0_FK = 512, Y0_FV = 1024, Y0_DQ = 1536, Y0_DK = 2048, Y0_DV = 2560, Y0_IQ = 3072, Y0_IK = 3328, Y0_FF = 3392, Y0_IW = 3400;
constexpr int Y1P = 2048;
constexpr int Y1_CQ = 0, Y1_CK = 512, Y1_CV = 1024, Y1_MCQ = 1536, Y1_MCKV = 1792, Y1_MKR = 1920;
constexpr int MQP = 768, MKVP = 1024;
constexpr float RMS_EPS = 1e-6f;
constexpr float LAMBDA_INIT = 0.35550906759309494f;
constexpr int NTHR = 512;
constexpr int LDS_BYTES = 144 * 1024, LDS_CTL_OFF = 144 * 1024 - 256;
constexpr int CW_KMAX = 12288;
constexpr int CW_Q = 8192;
constexpr int CW_BAR = 4096;

constexpr size_t MiB = 1u << 20;
constexpr size_t WS_CTL = 0;
constexpr size_t WS_WIN0 = 2 * MiB;
constexpr size_t WS_WOUT0 = 9 * MiB;
constexpr size_t WS_WGU0 = 11 * MiB;
constexpr size_t WS_WDN0 = 22 * MiB;
constexpr size_t WS_WIN1 = 28 * MiB;
constexpr size_t WS_WUQ = 32 * MiB;
constexpr size_t WS_WUKV = 33 * MiB;
constexpr size_t WS_WOUT1 = 34 * MiB;
constexpr size_t WS_WGU1 = 36 * MiB;
constexpr size_t WS_WDN1 = 47 * MiB;
constexpr size_t WS_SQA = 53 * MiB;
constexpr size_t WS_SQB = 54 * MiB;
constexpr size_t WS_ROPE = 56 * MiB;
constexpr size_t WS_TAB = 57 * MiB;
constexpr size_t WS_AUX = 58 * MiB;
constexpr size_t WS_LC = 62 * MiB;
constexpr size_t WS_SSQ = 64 * MiB;
constexpr size_t WS_KR = 68 * MiB;
constexpr size_t WS_XB = 72 * MiB;
constexpr size_t WS_MIX = 200 * MiB;
constexpr size_t WS_MASK = 328 * MiB;
constexpr size_t WS_BIG = 392 * MiB;
constexpr size_t WS_Y1 = WS_BIG;
constexpr size_t WS_MQ = WS_BIG + 256 * MiB;
constexpr size_t WS_MKV = WS_BIG + 352 * MiB;
constexpr size_t WS_END = WS_BIG + 480 * MiB;

#define WAVE_LDS_SYNC() asm volatile("s_waitcnt vmcnt(0) lgkmcnt(0)" ::: "memory")
__device__ __forceinline__ float bf2f(bf16 v) { return __uint_as_float(((unsigned)v) << 16); }
__device__ __forceinline__ bf16 f2bf(float f) { unsigned u = __float_as_uint(f); return (bf16)((u + 0x7fffu + ((u >> 16) & 1u)) >> 16); }
__device__ __forceinline__ unsigned pk2(float lo, float hi) { return (unsigned)f2bf(lo) | ((unsigned)f2bf(hi) << 16); }
__device__ __forceinline__ float wave_sum(float v) {
#pragma unroll
    for (int o = 1; o < 64; o <<= 1) v += __shfl_xor(v, o);
    return v;
}
__device__ __forceinline__ int t5_bucket_dev(int dist) {
    if (dist < 16) return dist;
    float d = (float)dist;
    int lb = 16 + (int)(logf(d / 16.0f) / 2.0794415416798357f * 16.0f);
    return lb < 31 ? lb : 31;
}

__device__ __forceinline__ int lane_id_v() { int l; asm volatile("v_mbcnt_lo_u32_b32 %0, -1, 0\n\tv_mbcnt_hi_u32_b32 %0, -1, %0" : "=v"(l)); return l & 63; }
#define XB_TMO      128
#define XB_XCNT(j)  (256  + 64 * (j))
#define XB_XSUB(j)  (1280 + 64 * (j))
#define XB_XGEN(j)  (2304 + 64 * (j))
#define XB_TOP      3328
#define XB_TOPGEN   3392
#define XCD_BAR_WORDS 3456
#define XB_SPIN_CAP (1u << 18)

__device__ __forceinline__ unsigned xb_ld(unsigned* p)              { return __hip_atomic_load(p, __ATOMIC_RELAXED, __HIP_MEMORY_SCOPE_AGENT); }
__device__ __forceinline__ unsigned xb_add(unsigned* p, unsigned v) { return __hip_atomic_fetch_add(p, v, __ATOMIC_RELAXED, __HIP_MEMORY_SCOPE_AGENT); }
__device__ __forceinline__ unsigned xb_xcc_id() { return (unsigned)__builtin_amdgcn_s_getreg((3 << 11) | 20) & 0xFu; }
#define XB_SPIN(cond, bar) do { unsigned _sp = 0; while (cond) { __builtin_amdgcn_s_sleep(1); \
    if ((++_sp & 255u) == 0u) { if (xb_ld(&(bar)[XB_TMO])) break; if (_sp > XB_SPIN_CAP) { atomicAdd(&(bar)[XB_TMO], 1u); break; } } } } while (0)

struct XcdBarrier {
    unsigned* bar; unsigned x; int wave;
    volatile LAS unsigned* st;
};

__device__ __forceinline__ XcdBarrier xcd_barrier_post(unsigned* bar, volatile LAS unsigned* st, int wave) {
    XcdBarrier b; b.bar = bar; b.x = xb_xcc_id(); b.st = st; b.wave = wave;
    if (wave == 0 && lane_id_v() == 0) (void)xb_add(&bar[XB_XCNT(b.x)], 1u);
    return b;
}
__device__ __forceinline__ void xcd_barrier_complete(unsigned* bar, unsigned x, unsigned& nloc, unsigned& nx) {
    const unsigned G = gridDim.x * gridDim.y * gridDim.z;
    unsigned sum, cnt, mine, sp = 0u;
    for (;;) {
        sum = 0u; cnt = 0u; mine = 0u;
#pragma unroll
        for (unsigned j = 0; j < 16; ++j) { const unsigned c = xb_ld(&bar[XB_XCNT(j)]); sum += c; cnt += (c > 0u) ? 1u : 0u; mine = (j == x) ? c : mine; }
        if (sum == G) break;
        __builtin_amdgcn_s_sleep(1);
        if ((++sp & 255u) == 0u) { if (xb_ld(&bar[XB_TMO])) break; if (sp > XB_SPIN_CAP) { atomicAdd(&bar[XB_TMO], 1u); break; } }
    }
    nloc = mine > 0u ? mine : 1u; nx = cnt > 0u ? cnt : 1u;
}

__device__ __forceinline__ void xcd_barrier(const XcdBarrier& b) {
    asm volatile("s_waitcnt vmcnt(0)" ::: "memory");
    __syncthreads();
    if (b.wave == 0 && lane_id_v() == 0) {
        unsigned* bar = b.bar;
        __builtin_amdgcn_s_waitcnt(0);
        unsigned nloc = b.st[0], nx = b.st[1];
        if (nloc == 0u) { xcd_barrier_complete(bar, b.x, nloc, nx); b.st[0] = nloc; b.st[1] = nx; }
        const unsigned old = xb_add(&bar[XB_XSUB(b.x)], 1u);
        const unsigned gen = old / nloc;
        if (old + 1u == (gen + 1u) * nloc) {
            __builtin_amdgcn_fence(__ATOMIC_RELEASE, "agent");
            asm volatile("s_waitcnt vmcnt(0)" ::: "memory");
            const unsigned og = xb_add(&bar[XB_TOP], 1u);
            const unsigned tg = og / nx;
            if (og + 1u == (tg + 1u) * nx) xb_add(&bar[XB_TOPGEN], 1u);
            else XB_SPIN(xb_ld(&bar[XB_TOPGEN]) == tg, bar);
            __builtin_amdgcn_fence(__ATOMIC_ACQUIRE, "agent");
            xb_add(&bar[XB_XGEN(b.x)], 1u);
            asm volatile("s_waitcnt vmcnt(0)" ::: "memory");
        } else {
            XB_SPIN(xb_ld(&bar[XB_XGEN(b.x)]) == gen, bar);
            __builtin_amdgcn_fence(__ATOMIC_ACQUIRE, "agent");
            asm volatile("s_waitcnt vmcnt(0)" ::: "memory");
        }
    }
    __syncthreads();
}

namespace pg8 {
#define PG8_LAS __attribute__((address_space(3)))
typedef unsigned short bf16_t;
typedef short bf16x8 __attribute__((ext_vector_type(8)));
typedef float f32x4 __attribute__((ext_vector_type(4)));
typedef unsigned u32x4 __attribute__((ext_vector_type(4)));
constexpr int BM = 256, BK = 64, HALF = 128, HTB = HALF * BK * 2  , STAGE_BYTES = 8 * HTB, NXCD = 8, WGM = 8;

__host__ __device__ __forceinline__ int lds_byte(int r, int c) { const int st = (r >> 4) * 2 + (c >> 5), rr = r & 15, cc = c & 31, ob = rr * 64 + cc * 2; return st * 1024 + (ob ^ (((ob >> 9) & 1) << 5)); }
__host__ __device__ __forceinline__ void stage_rc(int b, int& R, int& C) { const int st = b / 1024, sb = b % 1024, swz = sb ^ (((sb >> 9) & 1) << 5); R = (st >> 1) * 16 + swz / 64; C = (st & 1) * 32 + (swz % 64) / 2; }
__host__ __device__ __forceinline__ int perm32(int rho) { const int n = rho >> 4, i = rho & 15; return 8 * (i >> 2) + 4 * n + (i & 3); }

template <int V> struct BoolI { static constexpr int value = V; };
template <bool V> struct BoolC2 { static constexpr bool value = V; };
struct Unit { int pm, pn; };
struct Gemm { const bf16_t* A; const bf16_t* Bt; int M, N, K, lda, ldb; };

struct StaticOrder {
    int nM, nN, nwg, G, c;
    __host__ __device__ void init(int M, int N, int G_, int c_) { nM = M / BM; nN = N / BM; nwg = nM * nN; G = G_; c = c_; }
    __host__ __device__ bool next(int i, Unit& u) const {
        const long L = (long)i * G + c; if (L >= nwg) return false;
        int wgid = (int)L; { const int q = nwg / NXCD, r = nwg % NXCD, xcd = wgid % NXCD, off = wgid / NXCD; wgid = (xcd < r ? xcd * (q + 1) : r * (q + 1) + (xcd - r) * q) + off; }
        const int nig = WGM * nN, gid = wgid / nig, fm = gid * WGM, gsz = (nM - fm) < WGM ? (nM - fm) : WGM;
        u.pm = fm + ((wgid % nig) % gsz); u.pn = (wgid % nig) / gsz; return true;
    }
    __device__ __forceinline__ void a_ready(const Unit&) const {}
    __device__ __forceinline__ void done(const Unit&) const {}
};


__device__ __forceinline__ unsigned cvt_pk_bf16(float lo, float hi) { unsigned r; asm volatile("v_cvt_pk_bf16_f32 %0, %1, %2" : "=v"(r) : "v"(lo), "v"(hi)); return r; }
__device__ __forceinline__ float row_scale16(const float* ssq, int row, float inv_n) {
    const f32x4* p = (const f32x4*)(ssq + (size_t)row * 16);
    const f32x4 a = p[0], b = p[1], c = p[2], d = p[3];
    float s = a.x; s += a.y; s += a.z; s += a.w; s += b.x; s += b.y; s += b.z; s += b.w; s += c.x; s += c.y; s += c.z; s += c.w; s += d.x; s += d.y; s += d.z; s += d.w;
    return __builtin_amdgcn_rsqf(s * inv_n + 1e-6f);
}
__device__ __forceinline__ float row_scale4(const float* ssq, int row, float inv_n) {
    const f32x4 a = *(const f32x4*)(ssq + (size_t)row * 4);
    return __builtin_amdgcn_rsqf(((a.x + a.y) + (a.z + a.w)) * inv_n + 1e-6f);
}
__device__ __forceinline__ float row_ms16(const float* ssq, int row, float inv_n) {
    const f32x4* p = (const f32x4*)(ssq + (size_t)row * 16);
    const f32x4 a = p[0], b = p[1], c = p[2], d = p[3];
    float s = a.x; s += a.y; s += a.z; s += a.w; s += b.x; s += b.y; s += b.z; s += b.w; s += c.x; s += c.y; s += c.z; s += c.w; s += d.x; s += d.y; s += d.z; s += d.w;
    return s * inv_n + 1e-6f;
}
__device__ __forceinline__ f32x4 row_quad(const float* ssq, int row, int fq) { return *(const f32x4*)(ssq + (size_t)row * 16 + 4 * fq); }
__device__ __forceinline__ float row_ms_from_quad(f32x4 a, float inv_n) {
    float s = a.x; s += a.y; s += a.z; s += a.w;
    s += __shfl_xor(s, 16); s += __shfl_xor(s, 32);
    return s * inv_n + 1e-6f;
}
__device__ __forceinline__ float dot4(f32x4 v) { return (v.x * v.x + v.y * v.y) + (v.z * v.z + v.w * v.w); }

struct EpiScale {
    static constexpr bool PERM = true, AFTER_DRAIN = false;
    bf16_t* O; int ldo; const float* ssq; float* aux; int aux_pn; float* sA; int pnA; float* sB; int pnB;
    __device__ __forceinline__ void operator()(const f32x4 (&acc)[2][2][4][2], const Unit& u, int wr, int wc, int fr, int fq) const {
        float rsv[2][4];
        {
            f32x4 qd[2][4];
#pragma unroll
            for (int ai = 0; ai < 2; ++ai)
#pragma unroll
                for (int m = 0; m < 4; ++m) qd[ai][m] = row_quad(ssq, u.pm * BM + ai * HALF + wr * 64 + m * 16 + fr, fq);
#pragma unroll
            for (int ai = 0; ai < 2; ++ai)
#pragma unroll
                for (int m = 0; m < 4; ++m) asm volatile("" : "+v"(qd[ai][m]));
#pragma unroll
            for (int ai = 0; ai < 2; ++ai)
#pragma unroll
                for (int m = 0; m < 4; ++m) rsv[ai][m] = __builtin_amdgcn_rsqf(row_ms_from_quad(qd[ai][m], 1.0f / 1024.0f));
        }
#pragma unroll
        for (int ai = 0; ai < 2; ++ai)
#pragma unroll
            for (int m = 0; m < 4; ++m) {
                const int row = u.pm * BM + ai * HALF + wr * 64 + m * 16 + fr;
                const float rs = rsv[ai][m];
                float s0 = 0.f, s1 = 0.f;
#pragma unroll
                for (int bj = 0; bj < 2; ++bj) {
                    f32x4 v0, v1;
#pragma unroll
                    for (int j = 0; j < 4; ++j) { v0[j] = acc[ai][bj][m][0][j] * rs; v1[j] = acc[ai][bj][m][1][j] * rs; }
                    const int col = u.pn * BM + bj * HALF + wc * 32 + 8 * fq;
                    u32x4 w; w.x = cvt_pk_bf16(v0[0], v0[1]); w.y = cvt_pk_bf16(v0[2], v0[3]); w.z = cvt_pk_bf16(v1[0], v1[1]); w.w = cvt_pk_bf16(v1[2], v1[3]);
                    *(u32x4*)(O + (size_t)row * ldo + col) = w;
                    if (bj == 0 && u.pn == aux_pn && wc == 2) {
                        const f32x4 a0 = acc[ai][bj][m][0] * rs, a1 = acc[ai][bj][m][1] * rs;
                        if (fq == 0) { *(f32x4*)(aux + (size_t)row * 16) = a0; *(f32x4*)(aux + (size_t)row * 16 + 4) = a1; }
                        if (fq == 1) { *(f32x4*)(aux + (size_t)row * 16 + 8) = a0; }
                    }
                    if (u.pn == pnA || u.pn == pnB) { const f32x4 b0 = acc[ai][bj][m][0] * rs, b1 = acc[ai][bj][m][1] * rs; const float q = dot4(b0) + dot4(b1); if (bj == 0) s0 = q; else s1 = q; }
                }
                if (u.pn == pnA) { float s = s0 + s1; s += __shfl_xor(s, 16); s += __shfl_xor(s, 32); if (fq == 0) sA[(size_t)row * 4 + wc] = s; }
                if (u.pn == pnB) { float s = s0; s += __shfl_xor(s, 16); s += __shfl_xor(s, 32); if (fq == 0) sB[(size_t)row * 4 + wc] = s; }
            }
    }
};
template <bool RES_BF16, bool OUT_F32>
struct EpiResid {
    static constexpr bool PERM = true, AFTER_DRAIN = false;
    const float* resid; float* xout; bf16_t* xb; float* ssq;
    __device__ __forceinline__ void operator()(const f32x4 (&acc)[2][2][4][2], const Unit& u, int wr, int wc, int fr, int fq) const {
#pragma unroll
        for (int ai = 0; ai < 2; ++ai) {
            u32x4 rw[4][2];
            if (RES_BF16) {
#pragma unroll
                for (int m = 0; m < 4; ++m)
#pragma unroll
                    for (int bj = 0; bj < 2; ++bj)
                        rw[m][bj] = *(const u32x4*)(xb + (size_t)(u.pm * BM + ai * HALF + wr * 64 + m * 16 + fr) * 1024 + u.pn * BM + bj * HALF + wc * 32 + 8 * fq);
#pragma unroll
                for (int m = 0; m < 4; ++m)
#pragma unroll
                    for (int bj = 0; bj < 2; ++bj) asm volatile("" : "+v"(rw[m][bj]));
            }
#pragma unroll
            for (int m = 0; m < 4; ++m) {
                const int row = u.pm * BM + ai * HALF + wr * 64 + m * 16 + fr;
                float s = 0.f;
#pragma unroll
                for (int bj = 0; bj < 2; ++bj) {
                    const size_t off = (size_t)row * 1024 + u.pn * BM + bj * HALF + wc * 32 + 8 * fq;
                    f32x4 r0, r1;
                    if (RES_BF16) {
                        const u32x4 w_ = rw[m][bj];
                        r0 = (f32x4){__uint_as_float(w_.x << 16), __uint_as_float(w_.x & 0xffff0000u), __uint_as_float(w_.y << 16), __uint_as_float(w_.y & 0xffff0000u)};
                        r1 = (f32x4){__uint_as_float(w_.z << 16), __uint_as_float(w_.z & 0xffff0000u), __uint_as_float(w_.w << 16), __uint_as_float(w_.w & 0xffff0000u)};
                    } else { r0 = *(const f32x4*)(resid + off); r1 = *(const f32x4*)(resid + off + 4); }
                    f32x4 v0, v1;
#pragma unroll
                    for (int j = 0; j < 4; ++j) { v0[j] = acc[ai][bj][m][0][j] + r0[j]; v1[j] = acc[ai][bj][m][1][j] + r1[j]; }
                    if (OUT_F32) { *(f32x4*)(xout + off) = v0; *(f32x4*)(xout + off + 4) = v1; }
                    else {
                        u32x4 w; w.x = cvt_pk_bf16(v0[0], v0[1]); w.y = cvt_pk_bf16(v0[2], v0[3]); w.z = cvt_pk_bf16(v1[0], v1[1]); w.w = cvt_pk_bf16(v1[2], v1[3]);
                        *(u32x4*)(xb + off) = w;
                    }
                    s += dot4(v0) + dot4(v1);
                }
                s += __shfl_xor(s, 16); s += __shfl_xor(s, 32);
                if (fq == 0) ssq[(size_t)row * 16 + u.pn * 4 + wc] = s;
            }
        }
    }
};
__device__ __forceinline__ float silu_fast(float x) { return x * __builtin_amdgcn_rcpf(1.0f + __expf(-x)); }
struct EpiGU {
    static constexpr bool PERM = true, AFTER_DRAIN = false;
    bf16_t* Hd; int ldh; const float* ssq;
    __device__ __forceinline__ void operator()(const f32x4 (&acc)[2][2][4][2], const Unit& u, int wr, int wc, int fr, int fq) const {
        float xv[2][4];
        {
            f32x4 qd[2][4];
#pragma unroll
            for (int ai = 0; ai < 2; ++ai)
#pragma unroll
                for (int m = 0; m < 4; ++m) qd[ai][m] = row_quad(ssq, u.pm * BM + ai * HALF + wr * 64 + m * 16 + fr, fq);
#pragma unroll
            for (int ai = 0; ai < 2; ++ai)
#pragma unroll
                for (int m = 0; m < 4; ++m) asm volatile("" : "+v"(qd[ai][m]));
#pragma unroll
            for (int ai = 0; ai < 2; ++ai)
#pragma unroll
                for (int m = 0; m < 4; ++m) xv[ai][m] = row_ms_from_quad(qd[ai][m], 1.0f / 1024.0f);
        }
#pragma unroll
        for (int ai = 0; ai < 2; ++ai)
#pragma unroll
            for (int m = 0; m < 4; ++m) {
                const int row = u.pm * BM + ai * HALF + wr * 64 + m * 16 + fr;
                const float x = xv[ai][m], rs = __builtin_amdgcn_rsqf(x);
                const float ea = -1.4426950408889634f * rs;
                float h[8];
#pragma unroll
                for (int n = 0; n < 2; ++n)
#pragma unroll
                    for (int j = 0; j < 4; ++j) {
                        const float g = acc[ai][0][m][n][j], uu = acc[ai][1][m][n][j];
                        const float e = __builtin_amdgcn_exp2f(g * ea);
                        const float q = __builtin_amdgcn_rcpf(__builtin_fmaf(e, x, x));
                        h[n * 4 + j] = (g * uu) * q;
                    }
                u32x4 w; w.x = cvt_pk_bf16(h[0], h[1]); w.y = cvt_pk_bf16(h[2], h[3]); w.z = cvt_pk_bf16(h[4], h[5]); w.w = cvt_pk_bf16(h[6], h[7]);
                *(u32x4*)(Hd + (size_t)row * ldh + u.pn * HALF + wc * 32 + 8 * fq) = w;
            }
    }
};

struct EpiMkv {
    static constexpr bool PERM = true, AFTER_DRAIN = false;
    bf16_t* O; int ldo; const float* sq; float inv_n;
    __device__ __forceinline__ void operator()(const f32x4 (&acc)[2][2][4][2], const Unit& u, int wr, int wc, int fr, int fq) const {
        float rsv[2][4];
#pragma unroll
        for (int ai = 0; ai < 2; ++ai)
#pragma unroll
            for (int m = 0; m < 4; ++m) rsv[ai][m] = row_scale4(sq, u.pm * BM + ai * HALF + wr * 64 + m * 16 + fr, inv_n);
#pragma unroll
        for (int ai = 0; ai < 2; ++ai)
#pragma unroll
            for (int m = 0; m < 4; ++m) { float t_ = rsv[ai][m]; asm volatile("" : "+v"(t_)); rsv[ai][m] = t_; }
#pragma unroll
        for (int ai = 0; ai < 2; ++ai)
#pragma unroll
            for (int m = 0; m < 4; ++m) {
                const int row = u.pm * BM + ai * HALF + wr * 64 + m * 16 + fr;
                const float rs = rsv[ai][m];
#pragma unroll
                for (int bj = 0; bj < 2; ++bj) {
                    f32x4 v0, v1;
#pragma unroll
                    for (int j = 0; j < 4; ++j) { v0[j] = acc[ai][bj][m][0][j] * rs; v1[j] = acc[ai][bj][m][1][j] * rs; }
                    u32x4 w; w.x = cvt_pk_bf16(v0[0], v0[1]); w.y = cvt_pk_bf16(v0[2], v0[3]); w.z = cvt_pk_bf16(v1[0], v1[1]); w.w = cvt_pk_bf16(v1[2], v1[3]);
                    *(u32x4*)(O + (size_t)row * ldo + u.pn * BM + bj * HALF + wc * 32 + 8 * fq) = w;
                }
            }
    }
};

template <class Epi, class Sched, bool ALIGN_EPI = false, bool SP2 = false>
__device__ __forceinline__ void gemm_phase(PG8_LAS unsigned char* lds, const Gemm g, const Sched& S, const Epi& E, const int wid) {
    const int lane = lane_id_v(), tid = wid * 64 + lane,
              wr = wid >> 2, wc = wid & 3, fr = lane & 15, fq = lane >> 4;
    const int K = g.K, nt = K / BK;
    unsigned voffA[2], voffB[2];
#pragma unroll
    for (int i = 0; i < 2; ++i) { int R, C; stage_rc(tid * 16 + i * 8192, R, C); const int Rb = Epi::PERM ? ((R & ~31) + perm32(R & 31)) : R;
        voffA[i] = (unsigned)(R * g.lda + C) * 2u; voffB[i] = (unsigned)(Rb * g.ldb + C) * 2u; }
    const size_t kstep = (size_t)(BK * 2);
    const size_t hstepA = (size_t)HALF * g.lda * 2, hstepB = (size_t)HALF * g.ldb * 2;
    const size_t tstepA = 2 * hstepA, tstepB = 2 * hstepB;
    const unsigned ldsw = (unsigned)wid * 1024u;
    const int aoff = lds_byte(wr * 64 + fr, fq * 8), boff = lds_byte(wc * 32 + fr, fq * 8);
#define PG8_SA(b, h) (((b) * 2 + (h)) * HTB)
#define PG8_SB(b, h) ((4 + (b) * 2 + (h)) * HTB)
#define PG8_STAGE(bufoff, gbase, voff) do { _Pragma("unroll") for (int _i = 0; _i < 2; ++_i) \
        __builtin_amdgcn_global_load_lds((const unsigned*)((const char*)(gbase) + (voff)[_i]), (PG8_LAS unsigned*)(lds + (bufoff) + ldsw + _i * 8192), 16, 0, 0); } while (0)
#define PG8_LDA(dst, b, h) do { _Pragma("unroll") for (int m = 0; m < 4; ++m) _Pragma("unroll") for (int k = 0; k < 2; ++k) dst[m][k] = *(const PG8_LAS bf16x8*)(lds + PG8_SA(b, h) + aoff + m * 2048 + k * 1024); } while (0)
#define PG8_LDB(dst, b, h) do { _Pragma("unroll") for (int n = 0; n < 2; ++n) _Pragma("unroll") for (int k = 0; k < 2; ++k) dst[n][k] = *(const PG8_LAS bf16x8*)(lds + PG8_SB(b, h) + boff + n * 2048 + k * 1024); } while (0)
#define PG8_MMA(ai, bj, At, Bt) do { __builtin_amdgcn_s_setprio(1); _Pragma("unroll") for (int m = 0; m < 4; ++m) _Pragma("unroll") for (int n = 0; n < 2; ++n) _Pragma("unroll") for (int k = 0; k < 2; ++k) \
        acc[ai][bj][m][n] = __builtin_amdgcn_mfma_f32_16x16x32_bf16(Bt[n][k], At[m][k], acc[ai][bj][m][n], 0, 0, 0); __builtin_amdgcn_s_setprio(0); } while (0)
#define PG8_WAIT_V(n) asm volatile("s_waitcnt vmcnt(" #n ")" ::: "memory")
#define PG8_WAIT_L(n) asm volatile("s_waitcnt lgkmcnt(" #n ")" ::: "memory")
#define PG8_BAR __builtin_amdgcn_s_barrier()
#define PG8_SCHED __builtin_amdgcn_sched_barrier(0)
    Unit cur, nxt; int ui = 0;
    if (!S.next(0, cur)) return;
    f32x4 acc[2][2][4][2];
#pragma unroll
    for (int a = 0; a < 2; ++a)
#pragma unroll
        for (int b = 0; b < 2; ++b)
#pragma unroll
            for (int m = 0; m < 4; ++m)
#pragma unroll
                for (int n = 0; n < 2; ++n) acc[a][b][m][n] = (f32x4){0.f, 0.f, 0.f, 0.f};
    bf16x8 At[4][2], B0[2][2], B1[2][2];
    const char* cA = (const char*)g.A + (size_t)cur.pm * tstepA; const char* cB = (const char*)g.Bt + (size_t)cur.pn * tstepB;
    S.a_ready(cur);
    if constexpr (SP2) {
        PG8_STAGE(PG8_SB(0, 0), cB, voffB); PG8_STAGE(PG8_SB(0, 1), cB + hstepB, voffB); PG8_STAGE(PG8_SA(0, 0), cA, voffA); PG8_STAGE(PG8_SA(0, 1), cA + hstepA, voffA);
        if (wr == 1) PG8_BAR;
        PG8_WAIT_V(2); PG8_BAR;
        PG8_STAGE(PG8_SB(1, 0), cB + kstep, voffB); PG8_STAGE(PG8_SA(1, 0), cA + kstep, voffA); PG8_STAGE(PG8_SB(1, 1), cB + hstepB + kstep, voffB);
        PG8_WAIT_V(6); PG8_BAR;
    } else {
        PG8_STAGE(PG8_SB(0, 0), cB, voffB); PG8_STAGE(PG8_SA(0, 0), cA, voffA); PG8_STAGE(PG8_SB(0, 1), cB + hstepB, voffB); PG8_STAGE(PG8_SA(0, 1), cA + hstepA, voffA);
        if (wr == 1) PG8_BAR;
        PG8_WAIT_V(4); PG8_BAR;
        PG8_STAGE(PG8_SB(1, 0), cB + kstep, voffB); PG8_STAGE(PG8_SA(1, 0), cA + kstep, voffA); PG8_STAGE(PG8_SB(1, 1), cB + hstepB + kstep, voffB);
        PG8_WAIT_V(6); PG8_BAR;
    }
    for (;;) {
        const bool has_next = S.next(ui + 1, nxt);
        const char* nA = has_next ? (const char*)g.A + (size_t)nxt.pm * tstepA : cA; const char* nB = has_next ? (const char*)g.Bt + (size_t)nxt.pn * tstepB : cB;
        for (int t = 0; t < nt; t += 2) {
            const bool last = (t == nt - 2);
            const char* a1 = cA + (size_t)(t + 1) * kstep;
            const char* a2 = last ? nA : cA + (size_t)(t + 2) * kstep; const char* b2 = last ? nB : cB + (size_t)(t + 2) * kstep;
            const char* a3 = a2 + kstep; const char* b3 = b2 + kstep;
            if (last && has_next) S.a_ready(nxt);
            if constexpr (SP2) {
            PG8_LDB(B0, 0, 0); PG8_LDB(B1, 0, 1); PG8_SCHED; PG8_LDA(At, 0, 0); PG8_STAGE(PG8_SA(1, 1), a1 + hstepA, voffA);
            PG8_WAIT_V(8); PG8_WAIT_L(0); PG8_BAR; PG8_MMA(0, 0, At, B0); PG8_MMA(0, 1, At, B1); PG8_BAR; PG8_SCHED;
            PG8_LDA(At, 0, 1); PG8_STAGE(PG8_SB(0, 0), b2, voffB); PG8_STAGE(PG8_SB(0, 1), b2 + hstepB, voffB); PG8_STAGE(PG8_SA(0, 0), a2, voffA);
            PG8_WAIT_V(8); PG8_WAIT_L(0); PG8_BAR; PG8_MMA(1, 0, At, B0); PG8_MMA(1, 1, At, B1); PG8_BAR; PG8_SCHED;
            PG8_LDB(B0, 1, 0); PG8_LDB(B1, 1, 1); PG8_SCHED; PG8_LDA(At, 1, 0); PG8_STAGE(PG8_SA(0, 1), a2 + hstepA, voffA);
            PG8_WAIT_V(8); PG8_WAIT_L(0); PG8_BAR; PG8_MMA(0, 0, At, B0); PG8_MMA(0, 1, At, B1); PG8_BAR; PG8_SCHED;
            PG8_LDA(At, 1, 1); PG8_STAGE(PG8_SB(1, 0), b3, voffB); PG8_STAGE(PG8_SB(1, 1), b3 + hstepB, voffB); PG8_STAGE(PG8_SA(1, 0), a3, voffA);
            PG8_WAIT_V(8); PG8_WAIT_L(0); PG8_BAR; PG8_MMA(1, 0, At, B0); PG8_MMA(1, 1, At, B1); PG8_BAR; PG8_SCHED;
            } else {
            PG8_LDB(B0, 0, 0); PG8_SCHED; PG8_LDA(At, 0, 0); PG8_STAGE(PG8_SA(1, 1), a1 + hstepA, voffA);
            PG8_WAIT_L(8); PG8_BAR; PG8_WAIT_L(0); PG8_MMA(0, 0, At, B0); PG8_BAR; PG8_SCHED;
            PG8_LDB(B1, 0, 1); PG8_STAGE(PG8_SB(0, 0), b2, voffB);
            PG8_BAR; PG8_WAIT_L(0); PG8_MMA(0, 1, At, B1); PG8_BAR;
            PG8_LDA(At, 0, 1); PG8_STAGE(PG8_SA(0, 0), a2, voffA);
            PG8_BAR; PG8_WAIT_L(0); PG8_MMA(1, 0, At, B0); PG8_BAR; PG8_SCHED;
            PG8_STAGE(PG8_SB(0, 1), b2 + hstepB, voffB);
            PG8_WAIT_V(6); PG8_BAR; PG8_MMA(1, 1, At, B1); PG8_BAR;
            PG8_LDB(B0, 1, 0); PG8_SCHED; PG8_LDA(At, 1, 0); PG8_STAGE(PG8_SA(0, 1), a2 + hstepA, voffA);
            PG8_WAIT_L(8); PG8_BAR; PG8_WAIT_L(0); PG8_MMA(0, 0, At, B0); PG8_BAR; PG8_SCHED;
            PG8_LDB(B1, 1, 1); PG8_STAGE(PG8_SB(1, 0), b3, voffB);
            PG8_BAR; PG8_WAIT_L(0); PG8_MMA(0, 1, At, B1); PG8_BAR;
            PG8_LDA(At, 1, 1); PG8_STAGE(PG8_SA(1, 0), a3, voffA);
            PG8_BAR; PG8_WAIT_L(0); PG8_MMA(1, 0, At, B0); PG8_BAR; PG8_SCHED;
            PG8_STAGE(PG8_SB(1, 1), b3 + hstepB, voffB);
            PG8_WAIT_V(6); PG8_BAR; PG8_MMA(1, 1, At, B1); PG8_BAR;
            }
        }
        if constexpr (ALIGN_EPI) { if (wr == 0) PG8_BAR; }
        if constexpr (!Epi::AFTER_DRAIN) { E(acc, cur, wr, wc, fr, fq); S.done(cur); }
        if (!has_next) break;
#pragma unroll
        for (int a = 0; a < 2; ++a)
#pragma unroll
            for (int b = 0; b < 2; ++b)
#pragma unroll
                for (int m = 0; m < 4; ++m)
#pragma unroll
                    for (int n = 0; n < 2; ++n) acc[a][b][m][n] = (f32x4){0.f, 0.f, 0.f, 0.f};
        cur = nxt; cA = nA; cB = nB; ++ui;
        if constexpr (ALIGN_EPI) { if (wr == 1) PG8_BAR; }
    }
    PG8_WAIT_V(0);
    if constexpr (!ALIGN_EPI) { if (wr == 0) PG8_BAR; }
    PG8_BAR;
    if constexpr (Epi::AFTER_DRAIN) { E.fused(acc, cur, wr, wc, fr, fq, lds, wid, lane); S.done(cur); }
#undef PG8_SA
#undef PG8_SB
#undef PG8_STAGE
#undef PG8_LDA
#undef PG8_LDB
#undef PG8_MMA
#undef PG8_WAIT_V
#undef PG8_WAIT_L
#undef PG8_BAR
#undef PG8_SCHED
}
}


__device__ __forceinline__ int opaque_i(int x) { asm volatile("" : "+v"(x)); return x; }
__device__ __forceinline__ unsigned okey(float f) { const unsigned u = __float_as_uint(f); return (u & 0x80000000u) ? ~u : (u | 0x80000000u); }
namespace att {
typedef short bf16x8 __attribute__((ext_vector_type(8)));
typedef short s16x4 __attribute__((ext_vector_type(4)));
typedef float f32x16 __attribute__((ext_vector_type(16)));
enum { AM_FOX = 0, AM_DSA = 1, AM_DIFF = 2, AM_MLA = 3 };
constexpr float LOG2E = 1.4426950408889634f;
constexpr int OFF_LUT = 126 * 1024, OFF_MISC = OFF_LUT + 1024, ATT_LDS = OFF_MISC + 128;
static_assert(ATT_LDS <= 128 * 1024, "attention LDS map");

__device__ __forceinline__ void glds16(const void* gsrc, unsigned lds_dst) { unsigned keep;
    asm volatile("s_mov_b32 %0, m0\n\ts_mov_b32 m0, %2\n\ts_nop 0\n\tglobal_load_lds_dwordx4 %1, off\n\ts_mov_b32 m0, %0" : "=&s"(keep) : "v"(gsrc), "s"(lds_dst) : "memory"); }
__device__ __forceinline__ void glds4(const void* gsrc, unsigned lds_dst) { unsigned keep;
    asm volatile("s_mov_b32 %0, m0\n\ts_mov_b32 m0, %2\n\ts_nop 0\n\tglobal_load_lds_dword %1, off\n\ts_mov_b32 m0, %0" : "=&s"(keep) : "v"(gsrc), "s"(lds_dst) : "memory"); }
__device__ __forceinline__ void glds16s(const void* sbase, unsigned voff, unsigned lds_dst) { unsigned keep;
    asm volatile("s_mov_b32 %0, m0\n\ts_mov_b32 m0, %3\n\ts_nop 0\n\tglobal_load_lds_dwordx4 %1, %2\n\ts_mov_b32 m0, %0" : "=&s"(keep) : "v"(voff), "s"(sbase), "s"(lds_dst) : "memory"); }
__device__ __forceinline__ void glds4s(const void* sbase, unsigned voff, unsigned lds_dst) { unsigned keep;
    asm volatile("s_mov_b32 %0, m0\n\ts_mov_b32 m0, %3\n\ts_nop 0\n\tglobal_load_lds_dword %1, %2\n\ts_mov_b32 m0, %0" : "=&s"(keep) : "v"(voff), "s"(sbase), "s"(lds_dst) : "memory"); }
struct QPre { unsigned* ctr; unsigned pre; bool issued; };
struct Tens {
    const bf16* Q; int ldq;
    const bf16* K; int ldk;
    const bf16* K2; int ldk2;
    const bf16* V; int ldv;
    const float* lc;
    const unsigned* mask;
    const float* rcos; const float* rsin;
    float kmaxn;
    float scale2;
};
__device__ __forceinline__ float sum32f(float v) { auto rr = __builtin_amdgcn_permlane32_swap(__float_as_uint(v), __float_as_uint(v), false, false); return __uint_as_float(rr[0]) + __uint_as_float(rr[1]); }
__device__ __forceinline__ int crow(int reg, int h) { return (reg & 3) + 8 * (reg >> 2) + 4 * h; }

__device__ __forceinline__ bf16x8 split3_bf16(float v, int h) {
    const unsigned short b0 = f2bf(v); const float r1 = v - __uint_as_float(((unsigned)b0) << 16);
    const unsigned short b1 = f2bf(r1); const float r2 = r1 - __uint_as_float(((unsigned)b1) << 16);
    const unsigned short b2 = f2bf(r2);
    bf16x8 q = {0, 0, 0, 0, 0, 0, 0, 0};
    if (h == 0) { q[0] = (short)b0; q[1] = (short)b1; q[2] = (short)b2; }
    return q;
}
template <int MODE, int DQK, int DV>
__device__ __forceinline__ void attn_pass(LAS unsigned char* lds, const Tens& T, size_t rowbase, int q0, f32x16 (&o)[DV / 32], float& l_out, const int wave, QPre* qp = nullptr) {
    constexpr int NSTEP = DQK / 16, NDB = DV / 32, VROW = DV * 2;
    constexpr float THR = 8.0f;
    constexpr int NSUB = (MODE == AM_FOX) ? 1 : 2;
    constexpr int NRING = (MODE == AM_DIFF) ? 2 : 3;
    constexpr int KB_T = (DQK == 96) ? 12288 : 8192, VB_T = DV * 128, KSL = NSUB * KB_T, VSL = NSUB * VB_T;
    constexpr int OFF_K = 0, OFF_V = NRING * KSL, OFF_CS = OFF_V + NRING * VSL, OFF_MW = OFF_CS + ((MODE == AM_FOX) ? NRING * NSUB * 256 : 0), RING_END = OFF_MW + ((MODE == AM_DSA) ? NRING * NSUB * 2048 : 0);
    static_assert(RING_END <= OFF_LUT, "attention ring");
    const int lane = lane_id_v(), tid = wave * 64 + lane, r = lane & 31, h = lane >> 5;
    const int tq = q0 + wave * 32 + r;
    const int ntile = (q0 + 256) / 64;
    bf16x8 qf[NSTEP];
    {
        const bf16* qp = T.Q + (rowbase + tq) * (size_t)T.ldq + 8 * h;
#pragma unroll
        for (int s = 0; s < NSTEP; ++s) qf[s] = *(const bf16x8*)(qp + 16 * s);
    }
    {
        f32x4 c0 = {1.f, 1.f, 1.f, 1.f}, c1 = c0, s0 = {0.f, 0.f, 0.f, 0.f}, s1 = s0;
        if (MODE == AM_MLA) {
            c0 = *(const f32x4*)(T.rcos + tq * 16 + 8 * h); c1 = *(const f32x4*)(T.rcos + tq * 16 + 8 * h + 4);
            s0 = *(const f32x4*)(T.rsin + tq * 16 + 8 * h); s1 = *(const f32x4*)(T.rsin + tq * 16 + 8 * h + 4);
        }
#pragma unroll
        for (int s = 0; s < NSTEP; ++s) {
            if (MODE == AM_MLA && s == NSTEP - 1) continue;
            bf16x8 a = qf[s];
            if (MODE == AM_MLA && s == NSTEP - 2) {
                bf16x8 b2 = qf[NSTEP - 1];
#pragma unroll
                for (int j = 0; j < 8; ++j) {
                    const float x1 = __uint_as_float(((unsigned)(unsigned short)a[j]) << 16), x2 = __uint_as_float(((unsigned)(unsigned short)b2[j]) << 16);
                    const float cs = j < 4 ? c0[j & 3] : c1[j & 3], sn = j < 4 ? s0[j & 3] : s1[j & 3];
                    a[j] = (short)f2bf((x1 * cs - x2 * sn) * T.scale2); b2[j] = (short)f2bf((x2 * cs + x1 * sn) * T.scale2);
                }
                qf[NSTEP - 1] = b2;
            } else {
#pragma unroll
                for (int j = 0; j < 8; ++j) a[j] = (short)f2bf(__uint_as_float(((unsigned)(unsigned short)a[j]) << 16) * T.scale2);
            }
            qf[s] = a;
        }
    }
    float ct2 = 0.f, bq = 0.f;
    if (MODE == AM_FOX) {
        ct2 = T.lc[(rowbase + tq) * 8] * LOG2E;
        float qs = 0.f;
#pragma unroll
        for (int s = 0; s < NSTEP; ++s)
#pragma unroll
            for (int j = 0; j < 8; ++j) { const float v = __uint_as_float(((unsigned)(unsigned short)qf[s][j]) << 16); qs = fmaf(v, v, qs); }
        qs = sum32f(qs);
        bq = sqrtf(qs) * T.kmaxn * 1.001f + 1.0f;
    }
    const LAS float* lut = (const LAS float*)(lds + OFF_LUT);
    const int dk_key = 8 * wave + (lane >> 3), dk_col = ((lane & 7) ^ ((dk_key >> 1) & 7)) * 8;
    const int dr_key = 16 * wave + (lane >> 2), dr_col = ((lane & 3) ^ ((dr_key >> 2) & 3)) * 8;
    int dv_key[DV / 64], dv_col[DV / 64];
#pragma unroll
    for (int n = 0; n < DV / 64; ++n) {
        if (DV == 64) { dv_key[n] = 8 * wave + (lane >> 3); const int pos = lane & 7; dv_col[n] = (((pos >> 2) ^ ((dv_key[n] >> 1) & 1)) * 32) + (pos & 3) * 8; }
        else          { dv_key[n] = 8 * wave + 4 * n + (lane >> 4); const int pos = lane & 15; dv_col[n] = (((pos >> 2) ^ (dv_key[n] & 3)) * 32) + (pos & 3) * 8; }
    }
    const int dm_q = (wave * 64 + lane) >> 1, dm_kb = lane & 1;
    const unsigned lds0 = (unsigned)(uintptr_t)lds;
#define ATT_LDSADDR(x) ((unsigned)__builtin_amdgcn_readfirstlane((int)(lds0 + (unsigned)(x))))
    const unsigned kvo = (unsigned)(dk_key * T.ldk + dk_col) * 2u, rvo = (unsigned)(dr_key * T.ldk2 + dr_col) * 2u;
    unsigned vvo[DV / 64];
#pragma unroll
    for (int n = 0; n < DV / 64; ++n) vvo[n] = (unsigned)(dv_key[n] * T.ldv + dv_col[n]) * 2u;
    const unsigned cvo = (unsigned)lane * 32u, mvo = (unsigned)(wave * 64 + lane) * 4u;
    const char* const ubK = (const char*)(T.K + rowbase * (size_t)T.ldk);
    const char* const ubK2 = (MODE == AM_MLA) ? (const char*)(T.K2 + rowbase * (size_t)T.ldk2) : nullptr;
    const char* const ubV = (const char*)(T.V + rowbase * (size_t)T.ldv);
    const char* const ubC = (MODE == AM_FOX) ? (const char*)(T.lc + rowbase * 8) : nullptr;
    const char* const ubM = (MODE == AM_DSA) ? (const char*)(T.mask + ((rowbase / S * 128) * (size_t)S + q0) * 2) : nullptr;
#define ATT_DMA(jt, sl, sub) do { const size_t jt_ = (size_t)(jt); \
        glds16s(ubK + jt_ * (size_t)(128 * T.ldk), kvo, ATT_LDSADDR(OFF_K + (sl) * KSL + (sub) * KB_T + wave * 1024)); \
        if (DQK == 96) { if (wave < 4) glds16s(ubK2 + jt_ * (size_t)(128 * T.ldk2), rvo, ATT_LDSADDR(OFF_K + (sl) * KSL + (sub) * KB_T + 8192 + wave * 1024)); } \
        _Pragma("unroll") for (int n_ = 0; n_ < DV / 64; ++n_) \
            glds16s(ubV + jt_ * (size_t)(128 * T.ldv), vvo[n_], ATT_LDSADDR(OFF_V + (sl) * VSL + (sub) * VB_T + (wave * (DV / 64) + n_) * 1024)); \
        if (MODE == AM_FOX) { if (wave == 0) glds4s(ubC + jt_ * 2048, cvo, ATT_LDSADDR(OFF_CS + ((sl) * NSUB + (sub)) * 256)); } \
        if (MODE == AM_DSA) glds4s(ubM + jt_ * (size_t)(S * 8), mvo, ATT_LDSADDR(OFF_MW + ((sl) * NSUB + (sub)) * 2048 + wave * 256)); \
    } while (0)
#define ATT_ISSUE(st_, sl) do { _Pragma("unroll") for (int sb_ = 0; sb_ < NSUB; ++sb_) ATT_DMA(ATT_TILE((st_) * NSUB + sb_), sl, sb_); } while (0)
    const int nvm = 1 + ((DQK == 96 && wave < 4) ? 1 : 0) + DV / 64 + ((MODE == AM_FOX && wave == 0) ? 1 : 0) + ((MODE == AM_DSA) ? 1 : 0);
#define ATT_WAIT_PREV() do { if (NSUB == 1) { if (nvm == 2) asm volatile("s_waitcnt vmcnt(2)" ::: "memory"); else asm volatile("s_waitcnt vmcnt(3)" ::: "memory"); } \
                              else { if (nvm == 2) asm volatile("s_waitcnt vmcnt(4)" ::: "memory"); else asm volatile("s_waitcnt vmcnt(6)" ::: "memory"); } } while (0)
#define ATT_BAR() asm volatile("s_waitcnt lgkmcnt(0)\n\ts_barrier" ::: "memory")
    const unsigned koff = (unsigned)(r * 128), kswz = (unsigned)((r >> 1) & 7);
    const unsigned roff = (unsigned)(8192 + r * 64), rswz = (unsigned)((r >> 2) & 3);
    const int g16 = lane >> 4, qq = (lane & 15) >> 2, pp = lane & 3;
    const int vsw = (DV == 64) ? ((qq >> 1) & 1) : qq;
    const unsigned voff = (unsigned)((4 * (g16 >> 1) + qq) * VROW + (16 * (g16 & 1) + 4 * pp) * 2);
    const LAS unsigned char* kfa[NSTEP]; const LAS unsigned char* vfa[NDB];
#pragma unroll
    for (int s = 0; s < NSTEP; ++s) {
        kfa[s] = (s < 4) ? lds + OFF_K + koff + (((unsigned)(2 * s + h) ^ kswz) * 16) : lds + OFF_K + roff + (((unsigned)(2 * (s - 4) + h) ^ rswz) * 16);
        asm volatile("" : "+v"(kfa[s]));
    }
#pragma unroll
    for (int db = 0; db < NDB; ++db) { vfa[db] = lds + OFF_V + voff + (unsigned)((db ^ vsw) * 64); asm volatile("" : "+v"(vfa[db])); }

    float m = -64.0f, l = 0.f;
    bf16x8 kone = {0, 0, 0, 0, 0, 0, 0, 0}, qm = kone;
    if (MODE == AM_DSA) { if (h == 0) { kone[0] = (short)0x3F80; kone[1] = (short)0x3F80; kone[2] = (short)0x3F80; } qm = split3_bf16(64.0f, h); }
    f32x16 negm;
#pragma unroll
    for (int rg = 0; rg < 16; ++rg) negm[rg] = 64.0f;
#pragma unroll
    for (int i = 0; i < NDB; ++i) o[i] = f32x16{};
    const int jlast = (q0 + wave * 32) / 64;
    constexpr bool DESC = (MODE == AM_FOX);
#define ATT_TILE(i) (DESC ? (ntile - 1 - (i)) : (i))
    bool wdone = false;
    volatile LAS int* dflag = (volatile LAS int*)(lds + OFF_MISC + 16);
    const int nst = ntile / NSUB;
    ATT_ISSUE(0, 0);
    if (NRING == 3) ATT_ISSUE(1, 1);
    if (NRING == 3) ATT_WAIT_PREV(); else asm volatile("s_waitcnt vmcnt(0)" ::: "memory");
    ATT_BAR();
    auto tile_step = [&](auto slc_, const int st) __attribute__((always_inline)) -> bool {
        constexpr int sl = decltype(slc_)::value;
        { constexpr int sl2 = (sl + NRING - 1) % NRING; if (st + NRING - 1 < nst) ATT_ISSUE(st + NRING - 1, sl2); }
#pragma unroll
        for (int sub = 0; sub < NSUB; ++sub) {
        const int it = st * NSUB + sub;
        const int j = ATT_TILE(it);
        if (qp != nullptr && it == (MODE == AM_FOX ? 1 : ntile - 4)) { if (tid == 0) qp->pre = __hip_atomic_fetch_add(qp->ctr, 1u, __ATOMIC_RELAXED, __HIP_MEMORY_SCOPE_AGENT); qp->issued = true; }
        bool active = (j <= jlast);
        if (MODE == AM_FOX) {
            if (active && !wdone) {
                const float csn = *(const LAS float*)(lds + OFF_CS + (sl * NSUB + sub) * 256 + 63 * 4) * LOG2E;
                if (__all((ct2 - csn) + bq < m - 32.0f)) wdone = true;
            }
            active = active && !wdone;
        }
        if (active) {
            u32x2 mw = {0u, 0u};
            if (MODE == AM_DSA) mw = *(const LAS u32x2*)(lds + OFF_MW + (sl * NSUB + sub) * 2048 + (wave * 32 + r) * 8);
            f32x16 p[2];
            const int kbase = 64 * j;
            const bool diag = (kbase + 63 > q0 + wave * 32);
            const bool nearb = (kbase + 63 + 128 > q0 + wave * 32);
            constexpr bool POSTHOC = (MODE != AM_FOX);
            constexpr float BIG = 65536.0f;
            bool redo = (it == 0);
            float psum;
            for (;;) {
#pragma unroll
            for (int kb = 0; kb < 2; ++kb) {
                if (MODE == AM_FOX) {
                    const float ctm = ct2 - m;
#pragma unroll
                    for (int g = 0; g < 4; ++g) {
                        const f32x4 c = *(const LAS f32x4*)(lds + OFF_CS + (sl * NSUB + sub) * 256 + (32 * kb + 8 * g + 4 * h) * 4);
                        p[kb][4 * g + 0] = fmaf(-LOG2E, c.x, ctm); p[kb][4 * g + 1] = fmaf(-LOG2E, c.y, ctm); p[kb][4 * g + 2] = fmaf(-LOG2E, c.z, ctm); p[kb][4 * g + 3] = fmaf(-LOG2E, c.w, ctm);
                    }
                } else if (MODE == AM_DSA) {
#pragma unroll
                    for (int g = 0; g < 4; ++g) {
                        const unsigned nib = __builtin_amdgcn_ubfe(mw[kb], (unsigned)(8 * g + 4 * h), 4u);
                        const f32x4 t4 = *(const LAS f32x4*)(lds + OFF_LUT + 768 + nib * 16);
                        p[kb][4 * g + 0] = t4.x; p[kb][4 * g + 1] = t4.y; p[kb][4 * g + 2] = t4.z; p[kb][4 * g + 3] = t4.w;
                    }
                    p[kb] = __builtin_amdgcn_mfma_f32_32x32x16_bf16(kone, qm, p[kb], 0, 0, 0);
                }
#pragma unroll
                for (int s = 0; s < NSTEP; ++s) {
                    bf16x8 a;
                    if (s < 4) a = *(const LAS bf16x8*)(kfa[s] + sl * KSL + sub * KB_T + kb * 4096);
                    else       a = *(const LAS bf16x8*)(kfa[s] + sl * KSL + sub * KB_T + kb * 2048);
                    if ((MODE == AM_DIFF || MODE == AM_MLA) && s == 0)
                        asm("v_mfma_f32_32x32x16_bf16 %0, %1, %2, %3" : "=&v"(p[kb]) : "v"(a), "v"(qf[0]), "v"(negm));
                    else
                        p[kb] = __builtin_amdgcn_mfma_f32_32x32x16_bf16(a, qf[s], p[kb], 0, 0, 0);
                }
            }
            if (MODE == AM_DSA || MODE == AM_DIFF) {
                if (nearb) {
                    int dq = tq - kbase - 4 * h; asm volatile("" : "+v"(dq));
#pragma unroll
                    for (int kb = 0; kb < 2; ++kb)
#pragma unroll
                        for (int rg = 0; rg < 16; ++rg) { int dist = dq - (32 * kb + (rg & 3) + 8 * (rg >> 2)); dist = dist < 0 ? 0 : (dist > 128 ? 128 : dist); p[kb][rg] += lut[dist]; }
                }
            }
            if (MODE != AM_DSA && diag) {
                int dq = tq - kbase - 4 * h; asm volatile("" : "+v"(dq));
#pragma unroll
                for (int kb = 0; kb < 2; ++kb)
#pragma unroll
                    for (int rg = 0; rg < 16; ++rg) { if (32 * kb + (rg & 3) + 8 * (rg >> 2) > dq) p[kb][rg] = -INFINITY; }
            }
            if (!POSTHOC || redo) {
                float ta = fmaxf(fmaxf(p[0][0], p[0][1]), p[0][2]), tb = fmaxf(fmaxf(p[1][0], p[1][1]), p[1][2]);
#pragma unroll
                for (int rg = 3; rg < 15; rg += 2) { ta = fmaxf(fmaxf(ta, p[0][rg]), p[0][rg + 1]); tb = fmaxf(fmaxf(tb, p[1][rg]), p[1][rg + 1]); }
                float tmax = fmaxf(fmaxf(ta, tb), fmaxf(p[0][15], p[1][15]));
                { auto rr = __builtin_amdgcn_permlane32_swap(__float_as_uint(tmax), __float_as_uint(tmax), false, false); tmax = fmaxf(__uint_as_float(rr[0]), __uint_as_float(rr[1])); }
                if (POSTHOC || __builtin_expect(__any(tmax > THR), 0)) {
                    const float delta = fmaxf(tmax, 0.f);
                    m += delta;
                    const float alpha = __builtin_amdgcn_exp2f(-delta);
                    l *= alpha;
#pragma unroll
                    for (int kb = 0; kb < 2; ++kb)
#pragma unroll
                        for (int rg = 0; rg < 16; ++rg) p[kb][rg] -= delta;
#pragma unroll
                    for (int i = 0; i < NDB; ++i)
#pragma unroll
                        for (int rg = 0; rg < 16; ++rg) o[i][rg] *= alpha;
                    if (MODE == AM_DIFF || MODE == AM_MLA) {
#pragma unroll
                        for (int rg = 0; rg < 16; ++rg) negm[rg] = -m;
                    }
                    if (MODE == AM_DSA) qm = split3_bf16(-m, h);
                }
            }
            psum = 0.f;
#pragma unroll
            for (int rg = 0; rg < 16; ++rg) { const float e0 = __builtin_amdgcn_exp2f(p[0][rg]), e1 = __builtin_amdgcn_exp2f(p[1][rg]); p[0][rg] = e0; p[1][rg] = e1; psum += e0; psum += e1; }
            if (!POSTHOC || redo) break;
            if (__builtin_expect(!__any(!(psum <= BIG)), 1)) break;
            redo = true;
            }
            l += psum;
            bf16x8 pf[4];
#pragma unroll
            for (int kb = 0; kb < 2; ++kb)
#pragma unroll
                for (int s = 0; s < 2; ++s) {
                    u32x4 w;
                    w.x = pg8::cvt_pk_bf16(p[kb][8 * s + 0], p[kb][8 * s + 1]); w.y = pg8::cvt_pk_bf16(p[kb][8 * s + 2], p[kb][8 * s + 3]);
                    w.z = pg8::cvt_pk_bf16(p[kb][8 * s + 4], p[kb][8 * s + 5]); w.w = pg8::cvt_pk_bf16(p[kb][8 * s + 6], p[kb][8 * s + 7]);
                    pf[2 * kb + s] = __builtin_bit_cast(bf16x8, w);
                }
#pragma unroll
            for (int db = 0; db < NDB; ++db) {
#pragma unroll
                for (int ks = 0; ks < 4; ++ks) {
                    const LAS unsigned char* vp = vfa[db] + sl * VSL + sub * VB_T + (16 * ks) * VROW;
                    const s16x4 lo = __builtin_bit_cast(s16x4, __builtin_amdgcn_ds_read_tr16_b64_v4i16((LAS s16x4*)(vp)));
                    const s16x4 hi = __builtin_bit_cast(s16x4, __builtin_amdgcn_ds_read_tr16_b64_v4i16((LAS s16x4*)(vp + 8 * VROW)));
                    const bf16x8 a = {lo[0], lo[1], lo[2], lo[3], hi[0], hi[1], hi[2], hi[3]};
                    o[db] = __builtin_amdgcn_mfma_f32_32x32x16_bf16(a, pf[ks], o[db], 0, 0, 0);
                }
            }
        }
        }
        if (MODE == AM_FOX) { if (lane == 0) dflag[(st & 1) * 8 + wave] = wdone ? 1 : 0; }
        if (NRING == 3 && st + 2 < nst) ATT_WAIT_PREV(); else asm volatile("s_waitcnt vmcnt(0)" ::: "memory");
        ATT_BAR();
        if (MODE == AM_FOX) {
            int alld = 1;
#pragma unroll
            for (int w_ = 0; w_ < 8; ++w_) alld &= dflag[(st & 1) * 8 + w_];
            if (alld) return false;
        }
        return true;
    };
    for (int st = 0; st < nst; st += NRING) {
        if (!tile_step(pg8::BoolI<0>{}, st)) break;
        if (st + 1 >= nst) break;
        if (!tile_step(pg8::BoolI<1>{}, st + 1)) break;
        if (NRING == 3) {
            if (st + 2 >= nst) break;
            if (!tile_step(pg8::BoolI<(NRING == 3 ? 2 : 0)>{}, st + 2)) break;
        }
    }
    asm volatile("s_waitcnt vmcnt(0)" ::: "memory");
    __syncthreads();
#undef ATT_DMA
#undef ATT_ISSUE
#undef ATT_LDSADDR
#undef ATT_WAIT_PREV
#undef ATT_TILE
#undef ATT_BAR
    l_out = sum32f(l);
}

__device__ __forceinline__ void swap_pair(u32x2& a, u32x2& b) {
    { auto r_ = __builtin_amdgcn_permlane32_swap(a.x, b.x, false, false); a.x = r_[0]; b.x = r_[1]; }
    { auto r_ = __builtin_amdgcn_permlane32_swap(a.y, b.y, false, false); a.y = r_[0]; b.y = r_[1]; }
}
template <int DV>
__device__ __forceinline__ void store_o(bf16* Orow, const f32x16 (&o)[DV / 32], float l, int h) {
    const float il = 1.0f / l;
#pragma unroll
    for (int db = 0; db < DV / 32; ++db)
#pragma unroll
        for (int gp = 0; gp < 2; ++gp) {
            u32x2 a, b;
            a.x = pg8::cvt_pk_bf16(o[db][8 * gp + 0] * il, o[db][8 * gp + 1] * il); a.y = pg8::cvt_pk_bf16(o[db][8 * gp + 2] * il, o[db][8 * gp + 3] * il);
            b.x = pg8::cvt_pk_bf16(o[db][8 * gp + 4] * il, o[db][8 * gp + 5] * il); b.y = pg8::cvt_pk_bf16(o[db][8 * gp + 6] * il, o[db][8 * gp + 7] * il);
            swap_pair(a, b);
            const u32x4 w = {a.x, a.y, b.x, b.y};
            *(u32x4*)(Orow + 32 * db + 16 * gp + 8 * h) = w;
        }
}
__device__ __forceinline__ int next_unit_pre(QPre& qp, unsigned* counters, int per_queue, LAS unsigned char* lds, int slot_off, const int wave) {
    volatile LAS int* slot = (volatile LAS int*)(lds + opaque_i(slot_off));
    const unsigned x = ((unsigned)__builtin_amdgcn_s_getreg((3 << 11) | 20)) & 7u;
    qp.ctr = counters + x * 64;
    if (wave == 0 && lane_id_v() == 0) {
        int res = -1;
        unsigned k0 = 0u;
        if (qp.issued) { if (qp.pre < (unsigned)per_queue) res = (int)(x * (unsigned)per_queue + qp.pre); k0 = 1u; }
        if (res < 0) {
            for (unsigned k = k0; k < 8u; ++k) {
                const unsigned q = (x + k) & 7u;
                if (k > 0 && __hip_atomic_load(counters + q * 64, __ATOMIC_RELAXED, __HIP_MEMORY_SCOPE_AGENT) >= (unsigned)per_queue) continue;
                const unsigned idx = __hip_atomic_fetch_add(counters + q * 64, 1u, __ATOMIC_RELAXED, __HIP_MEMORY_SCOPE_AGENT);
                if (idx < (unsigned)per_queue) { res = (int)(q * (unsigned)per_queue + idx); break; }
            }
        }
        slot[0] = res;
    }
    qp.issued = false;
    __syncthreads();
    const int u = __builtin_amdgcn_readfirstlane(slot[0]);
    __syncthreads();
    return u;
}
__device__ __forceinline__ int next_unit(unsigned* counters, int per_queue, LAS unsigned char* lds, int slot_off, const int wave) {
    volatile LAS int* slot = (volatile LAS int*)(lds + slot_off);
    if (wave == 0 && lane_id_v() == 0) {
        const unsigned x = ((unsigned)__builtin_amdgcn_s_getreg((3 << 11) | 20)) & 7u;
        int res = -1;
        for (unsigned k = 0; k < 8u; ++k) {
            const unsigned q = (x + k) & 7u;
            if (k > 0 && __hip_atomic_load(counters + q * 64, __ATOMIC_RELAXED, __HIP_MEMORY_SCOPE_AGENT) >= (unsigned)per_queue) continue;
            const unsigned idx = __hip_atomic_fetch_add(counters + q * 64, 1u, __ATOMIC_RELAXED, __HIP_MEMORY_SCOPE_AGENT);
            if (idx < (unsigned)per_queue) { res = (int)(q * (unsigned)per_queue + idx); break; }
        }
        slot[0] = res;
    }
    __syncthreads();
    const int u = __builtin_amdgcn_readfirstlane(slot[0]);
    __syncthreads();
    return u;
}
}

namespace dsa {
typedef att::bf16x8 bf16x8;
typedef att::f32x16 f32x16;
constexpr int HROW = 257;
constexpr int OFF_HIST = 0, OFF_GT = 33024, OFF_EQ = OFF_GT + 33024, OFF_PFX = OFF_EQ + 33024, OFF_NEED = OFF_PFX + 128, OFF_SLOT = OFF_NEED + 128, DSA_LDS = OFF_SLOT + 64;


__device__ __forceinline__ void write_mask_T(const LAS unsigned* gsrc, unsigned* maskg, int b, int t0, int tid) {
    const int q = tid & 31, jl = tid >> 5;
#pragma unroll
    for (int k = 0; k < 8; ++k) {
        const int jp = jl + 16 * k;
        u32x2 w; w.x = gsrc[q * HROW + 2 * jp]; w.y = gsrc[q * HROW + 2 * jp + 1];
        *(u32x2*)(maskg + (((size_t)(b * 128 + jp) * S) + t0 + q) * 2) = w;
    }
}
template <int LEVEL>
__device__ __forceinline__ void pass(LAS unsigned char* lds, const bf16* kbase  , int g, int t0, const bf16x8 (&qf)[4][4], const f32x4 lo4, const f32x4 hi4,
                                     int wave, int r, int h2) {
    LAS unsigned* hist = (LAS unsigned*)(lds + OFF_HIST);
    LAS unsigned* gtm = (LAS unsigned*)(lds + OFF_GT);
    LAS unsigned* eqm = (LAS unsigned*)(lds + OFF_EQ);
    const int tq = t0 + r;
    const unsigned pfx = ((const LAS unsigned*)(lds + OFF_PFX))[r];
    const bool selall = tq < 256;
    bf16x8 kf[4], kn[4];
    const bf16* kp = kbase + (size_t)r * Y0P + 8 * h2;
    if (wave <= g) {
#pragma unroll
        for (int s = 0; s < 4; ++s) kf[s] = *(const bf16x8*)(kp + (size_t)(32 * wave) * Y0P + 16 * s);
    }
    for (int kt = wave; kt <= g; kt += 8) {
        if (kt + 8 <= g) {
#pragma unroll
            for (int s = 0; s < 4; ++s) kn[s] = *(const bf16x8*)(kp + (size_t)(32 * (kt + 8)) * Y0P + 16 * s);
        }
        f32x16 acc[4];
#pragma unroll
        for (int hd = 0; hd < 4; ++hd) {
            acc[hd] = f32x16{};
#pragma unroll
            for (int s = 0; s < 4; ++s) acc[hd] = __builtin_amdgcn_mfma_f32_32x32x16_bf16(kf[s], qf[hd][s], acc[hd], 0, 0, 0);
        }
        unsigned gtw = 0u, eqw = 0u;
#pragma unroll
        for (int rg = 0; rg < 16; ++rg) {
            const int cr = att::crow(rg, h2);
            float sv = (__builtin_amdgcn_fmed3f(acc[0][rg], lo4.x, hi4.x) + __builtin_amdgcn_fmed3f(acc[1][rg], lo4.y, hi4.y)) + (__builtin_amdgcn_fmed3f(acc[2][rg], lo4.z, hi4.z) + __builtin_amdgcn_fmed3f(acc[3][rg], lo4.w, hi4.w));
            sv += 0.0f;
            const unsigned ok = okey(sv);
            const bool valid = (32 * kt + cr) <= tq;
            if (LEVEL < 4) {
                const bool match = valid && (LEVEL == 0 || (ok >> ((32 - 8 * LEVEL) & 31)) == pfx);
                if (match) atomicAdd((unsigned*)&hist[r * HROW + ((ok >> (24 - 8 * (LEVEL & 3))) & 255u)], 1u);
            } else {
                const bool gt = valid && (selall || ok > pfx), eq = valid && !selall && ok == pfx;
                gtw |= (gt ? 1u : 0u) << cr; eqw |= (eq ? 1u : 0u) << cr;
            }
        }
        if (LEVEL == 4) {
            gtw |= (unsigned)__shfl_xor((int)gtw, 32); eqw |= (unsigned)__shfl_xor((int)eqw, 32);
            if (h2 == 0) { gtm[r * HROW + kt] = gtw; eqm[r * HROW + kt] = eqw; }
        }
#pragma unroll
        for (int s = 0; s < 4; ++s) kf[s] = kn[s];
    }
}

__device__ __forceinline__ void pick_digit(LAS unsigned char* lds, int tid) {
    LAS unsigned* hist = (LAS unsigned*)(lds + OFF_HIST);
    LAS unsigned* pfxp = (LAS unsigned*)(lds + OFF_PFX);
    LAS int* needp = (LAS int*)(lds + OFF_NEED);
    const int q = tid >> 4, i = tid & 15;
    unsigned c[16]; unsigned cs = 0u;
#pragma unroll
    for (int k = 0; k < 16; ++k) { c[k] = hist[q * HROW + 16 * i + k]; cs += c[k]; }
    unsigned v = cs;
#pragma unroll
    for (int o = 1; o < 16; o <<= 1) { const unsigned t = (unsigned)__shfl_down((int)v, o, 16); if (i + o < 16) v += t; }
    const unsigned above = v - cs;
    const unsigned need = (unsigned)needp[q];
    __syncthreads();
    if (above < need && need <= above + cs) {
        unsigned cum = above; int digit = 0; unsigned nn = need;
        bool done = false;
#pragma unroll
        for (int k = 15; k >= 0; --k) { if (!done) { if (cum + c[k] >= need) { digit = 16 * i + k; nn = need - cum; done = true; } else cum += c[k]; } }
        pfxp[q] = (pfxp[q] << 8) | (unsigned)digit; needp[q] = (int)nn;
    }
#pragma unroll
    for (int k = 0; k < 16; ++k) hist[q * HROW + 16 * i + k] = 0u;
    if (i == 0) hist[q * HROW + 256] = 0u;
    __syncthreads();
}

__device__ __forceinline__ void run_unit(LAS unsigned char* lds, const bf16* y0, const float* aux, unsigned* maskg, int b, int g, int tid_in, int wave, int lane) {
    const int tid = opaque_i(tid_in);
    const int lane_o = opaque_i(lane); const int r = lane_o & 31, h2 = lane_o >> 5, t0 = 32 * g;
    const size_t rowbase = (size_t)b * S;
    LAS unsigned* hist = (LAS unsigned*)(lds + OFF_HIST);
    LAS unsigned* gtm = (LAS unsigned*)(lds + OFF_GT);
    LAS unsigned* eqm = (LAS unsigned*)(lds + OFF_EQ);
    for (int i = tid; i < (3 * 33024) / 4; i += NTHR) ((LAS unsigned*)(lds + OFF_HIST))[i] = 0u;
    if (tid < 32) { ((LAS unsigned*)(lds + OFF_PFX))[tid] = 0u; ((LAS int*)(lds + OFF_NEED))[tid] = 256; }
    bf16x8 qf[4][4];
    {
        const bf16* qp = y0 + (rowbase + t0 + r) * (size_t)Y0P + Y0_IQ + 8 * h2;
#pragma unroll
        for (int hd = 0; hd < 4; ++hd)
#pragma unroll
            for (int s = 0; s < 4; ++s) qf[hd][s] = *(const bf16x8*)(qp + hd * 64 + 16 * s);
    }
    const f32x4 w4 = *(const f32x4*)(aux + (rowbase + t0 + r) * 16 + 8);
    f32x4 lo4, hi4;
#pragma unroll
    for (int hd = 0; hd < 4; ++hd) {
        const float wsc = w4[hd] * 0.0625f;
        lo4[hd] = (w4[hd] >= 0.f) ? 0.f : -INFINITY; hi4[hd] = (w4[hd] >= 0.f) ? INFINITY : 0.f;
#pragma unroll
        for (int s = 0; s < 4; ++s) {
            bf16x8 a = qf[hd][s];
#pragma unroll
            for (int j = 0; j < 8; ++j) a[j] = (short)f2bf(__uint_as_float(((unsigned)(unsigned short)a[j]) << 16) * wsc);
            qf[hd][s] = a;
        }
    }
    const bf16* kbase = y0 + rowbase * (size_t)Y0P + Y0_IK;
    __syncthreads();
    pass<0>(lds, kbase, g, t0, qf, lo4, hi4, wave, r, h2); __syncthreads(); pick_digit(lds, tid);
    pass<1>(lds, kbase, g, t0, qf, lo4, hi4, wave, r, h2); __syncthreads(); pick_digit(lds, tid);
    pass<2>(lds, kbase, g, t0, qf, lo4, hi4, wave, r, h2); __syncthreads(); pick_digit(lds, tid);
    pass<3>(lds, kbase, g, t0, qf, lo4, hi4, wave, r, h2); __syncthreads(); pick_digit(lds, tid);
    pass<4>(lds, kbase, g, t0, qf, lo4, hi4, wave, r, h2); __syncthreads();
    {
        const int q = tid >> 4, i = tid & 15;
        unsigned e[16]; int cs = 0;
#pragma unroll
        for (int k = 0; k < 16; ++k) { e[k] = eqm[q * HROW + 16 * i + k]; cs += __popc(e[k]); }
        int v = cs;
#pragma unroll
        for (int o = 1; o < 16; o <<= 1) { const int t = __shfl_up(v, o, 16); if (i >= o) v += t; }
        int remaining = ((const LAS int*)(lds + OFF_NEED))[q] - (v - cs);
        unsigned outw[16];
#pragma unroll
        for (int k = 0; k < 16; ++k) {
            unsigned take = 0u;
            if (remaining > 0) {
                const int pc = __popc(e[k]);
                if (pc <= remaining) { take = e[k]; remaining -= pc; }
                else { unsigned mm = e[k]; for (int j = 0; j < remaining; ++j) { const unsigned low = mm & (0u - mm); take |= low; mm ^= low; } remaining = 0; }
            }
            outw[k] = gtm[q * HROW + 16 * i + k] | take;
        }
#pragma unroll
        for (int k = 0; k < 16; ++k) gtm[q * HROW + 16 * i + k] = outw[k];
    }
    __syncthreads();
    write_mask_T(gtm, maskg, b, t0, tid);
    __syncthreads();
}
constexpr int NB2 = 480, HROW2 = 481, CAP2 = 256;
constexpr int OFF2_SV = 102400;
static_assert(OFF2_SV + 8 * 4096 <= LDS_CTL_OFF, "dsa stash");
constexpr int OFF2_HIST = 0, OFF2_CAND = 0, OFF2_GT = 65536, OFF2_TB = OFF2_GT + 33024, OFF2_NEED = OFF2_TB + 128, OFF2_CNT = OFF2_NEED + 128, OFF2_FLAG = OFF2_CNT + 128;
static_assert(OFF2_FLAG + 64 <= OFF_SLOT + 100000 && 32 * HROW2 * 4 <= 65536, "dsa LDS map");

__device__ __forceinline__ int bin2(float sv, int zi) {
    const unsigned u = __float_as_uint(sv);
    int c = (int)((u >> 20) & 0x7FFu) - 832;
    c = c < 0 ? 0 : (c > 207 ? 207 : c);
    int b = (u >> 31) ? (207 - c) : (272 + c);
    if (sv == 0.0f) b = 208 + zi;
    return b;
}

__device__ __forceinline__ float fadd_s(float a, float b) { float r; asm("v_add_f32 %0, %1, %2" : "=v"(r) : "v"(a), "v"(b)); return r; }
template <int STAGE>
__device__ __forceinline__ void pass2(LAS unsigned char* lds, const bf16* kbase, int g, int t0, const bf16x8 (&qf)[4][4], const f32x4 lo4, const f32x4 hi4, int wave, int r, int h2) {
    LAS unsigned* hist = (LAS unsigned*)(lds + OFF2_HIST);
    LAS unsigned long long* cand = (LAS unsigned long long*)(lds + OFF2_CAND);
    LAS unsigned* gtm = (LAS unsigned*)(lds + OFF2_GT);
    LAS unsigned* cntp = (LAS unsigned*)(lds + OFF2_CNT);
    const int tq = t0 + r;
    const int tb = (STAGE == 1) ? ((const LAS int*)(lds + OFF2_TB))[r] : 0;
    bf16x8 kf[4], kn[4];
    const bf16* kp = kbase + (size_t)r * Y0P + 8 * h2;
    auto tile = [&](auto which_, const int kt, auto diag_) __attribute__((always_inline)) {
        constexpr bool DIAG = decltype(diag_)::value, WN = decltype(which_)::value;
        f32x16 acc[4];
#pragma unroll
        for (int hd = 0; hd < 4; ++hd) {
            acc[hd] = f32x16{};
#pragma unroll
            for (int s = 0; s < 4; ++s) acc[hd] = __builtin_amdgcn_mfma_f32_32x32x16_bf16(WN ? kn[s] : kf[s], qf[hd][s], acc[hd], 0, 0, 0);
        }
        float t01[16];
#pragma unroll
        for (int rg = 0; rg < 16; ++rg) t01[rg] = fadd_s(__builtin_amdgcn_fmed3f(acc[0][rg], lo4.x, hi4.x), __builtin_amdgcn_fmed3f(acc[1][rg], lo4.y, hi4.y));
        __builtin_amdgcn_sched_group_barrier(0x008, 8, 0);
#pragma unroll
        for (int i_ = 0; i_ < 8; ++i_) { __builtin_amdgcn_sched_group_barrier(0x008, 1, 0); __builtin_amdgcn_sched_group_barrier(0x002, 4, 0); }
        const int zi = (8191 - 32 * kt) >> 7;
        const int lim = tq - 32 * kt - 4 * h2;
        unsigned gtw = 0u, eqw = 0u;
        float svq[16];
#pragma unroll
        for (int rg = 0; rg < 16; ++rg) {
            const int c0 = att::crow(rg, 0);
            float sv = fadd_s(t01[rg], fadd_s(__builtin_amdgcn_fmed3f(acc[2][rg], lo4.z, hi4.z), __builtin_amdgcn_fmed3f(acc[3][rg], lo4.w, hi4.w)));
            const int b = bin2(sv, zi);
            const bool valid = !DIAG || c0 <= lim;
            if (STAGE == 0) {
                atomicAdd((unsigned*)&hist[r * HROW2 + (valid ? b : NB2)], 1u);
            } else {
                if (valid && b > tb) gtw |= 1u << c0;
                if (valid && b == tb) eqw |= 1u << c0;
                svq[rg] = sv;
            }
        }
        if (STAGE == 1) {
            LAS unsigned char* st = lds + OFF2_SV + wave * 4096 + (r + 32 * h2) * 16;
#pragma unroll
            for (int q = 0; q < 4; ++q) *(LAS f32x4*)(st + q * 1024) = (f32x4){svq[4 * q], svq[4 * q + 1], svq[4 * q + 2], svq[4 * q + 3]};
            unsigned e = eqw;
            while (__any(e != 0u)) {
                if (e != 0u) {
                    const int c = __builtin_ctz(e); e &= e - 1u;
                    float svv = *(const LAS float*)(st + (c >> 3) * 1024 + (c & 3) * 4);
                    svv = fadd_s(svv, 0.0f);
                    const unsigned pos = atomicAdd((unsigned*)&cntp[r], 1u);
                    if (pos < (unsigned)CAP2) cand[r * CAP2 + pos] = ((unsigned long long)okey(svv) << 13) | (unsigned long long)(8191 - (32 * kt + c + 4 * h2));
                }
            }
            gtw <<= 4 * h2;
            { auto rr = __builtin_amdgcn_permlane32_swap(gtw, gtw, false, false); gtw = rr[0] | rr[1]; }
            if (h2 == 0) gtm[r * HROW + kt] = gtw;
        }
    };
#define DSA2_LOADK(dst, kt_) do { _Pragma("unroll") for (int s = 0; s < 4; ++s) dst[s] = *(const bf16x8*)(kp + (size_t)(32 * (kt_)) * Y0P + 16 * s); } while (0)
    int kt = wave;
    if (kt <= g) DSA2_LOADK(kf, kt);
    for (;;) {
        if (kt > g) break;
        if (kt + 8 <= g) DSA2_LOADK(kn, kt + 8);
        if (kt == g) { tile(pg8::BoolC2<false>{}, kt, pg8::BoolC2<true>{}); break; }
        tile(pg8::BoolC2<false>{}, kt, pg8::BoolC2<false>{});
        kt += 8;
        if (kt > g) break;
        if (kt + 8 <= g) DSA2_LOADK(kf, kt + 8);
        if (kt == g) { tile(pg8::BoolC2<true>{}, kt, pg8::BoolC2<true>{}); break; }
        tile(pg8::BoolC2<true>{}, kt, pg8::BoolC2<false>{});
        kt += 8;
    }
#undef DSA2_LOADK
}

__device__ __forceinline__ bool run_unit2(LAS unsigned char* lds, const bf16* y0, const float* aux, unsigned* maskg, int b, int g, int tid_in, int wave, int lane) {
    const int tid = opaque_i(tid_in);
    const int lane_o = opaque_i(lane); const int r = lane_o & 31, h2 = lane_o >> 5, t0 = 32 * g;
    const size_t rowbase = (size_t)b * S;
    LAS unsigned* hist = (LAS unsigned*)(lds + OFF2_HIST);
    LAS unsigned* gtm = (LAS unsigned*)(lds + OFF2_GT);
    for (int i = tid; i < (OFF2_TB) / 4; i += NTHR) ((LAS unsigned*)lds)[i] = 0u;
    if (tid < 32) { ((LAS unsigned*)(lds + OFF2_CNT))[tid] = 0u; }
    if (tid == 0) ((LAS int*)(lds + OFF2_FLAG))[0] = 0;
    bf16x8 qf[4][4];
    {
        const bf16* qp = y0 + (rowbase + t0 + r) * (size_t)Y0P + Y0_IQ + 8 * h2;
#pragma unroll
        for (int hd = 0; hd < 4; ++hd)
#pragma unroll
            for (int s = 0; s < 4; ++s) qf[hd][s] = *(const bf16x8*)(qp + hd * 64 + 16 * s);
    }
    const f32x4 w4 = *(const f32x4*)(aux + (rowbase + t0 + r) * 16 + 8);
    f32x4 lo4, hi4;
#pragma unroll
    for (int hd = 0; hd < 4; ++hd) {
        const float wsc = w4[hd] * 0.0625f;
        lo4[hd] = (w4[hd] >= 0.f) ? 0.f : -INFINITY; hi4[hd] = (w4[hd] >= 0.f) ? INFINITY : 0.f;
#pragma unroll
        for (int s = 0; s < 4; ++s) {
            bf16x8 a = qf[hd][s];
#pragma unroll
            for (int j = 0; j < 8; ++j) a[j] = (short)f2bf(__uint_as_float(((unsigned)(unsigned short)a[j]) << 16) * wsc);
            qf[hd][s] = a;
        }
    }
    const bf16* kbase = y0 + rowbase * (size_t)Y0P + Y0_IK;
    __syncthreads();
    pass2<0>(lds, kbase, g, t0, qf, lo4, hi4, wave, r, h2);
    __syncthreads();
    {
        const int q = tid >> 4, i = tid & 15;
        unsigned c[30]; unsigned cs = 0u;
#pragma unroll
        for (int k = 0; k < 30; ++k) { c[k] = hist[q * HROW2 + 30 * i + k]; cs += c[k]; }
        unsigned v = cs;
#pragma unroll
        for (int o = 1; o < 16; o <<= 1) { const unsigned t = (unsigned)__shfl_down((int)v, o, 16); if (i + o < 16) v += t; }
        const unsigned above = v - cs;
        if (i == 0) { const bool selall = (t0 + q) < 256; if (selall || v < 256u) { ((LAS int*)(lds + OFF2_TB))[q] = -1; ((LAS int*)(lds + OFF2_NEED))[q] = 0; } }
        if (!((t0 + q) < 256) && above < 256u && 256u <= above + cs) {
            unsigned cum = above; bool done = false;
#pragma unroll
            for (int k = 29; k >= 0; --k) { if (!done) { if (cum + c[k] >= 256u) { ((LAS int*)(lds + OFF2_TB))[q] = 30 * i + k; ((LAS int*)(lds + OFF2_NEED))[q] = (int)(256u - cum);
                        if (c[k] > (unsigned)CAP2) ((LAS int*)(lds + OFF2_FLAG))[0] = 1; done = true; } else cum += c[k]; } }
        }
    }
    __syncthreads();
    if (((const LAS int*)(lds + OFF2_FLAG))[0] != 0) { __syncthreads(); return false; }
    for (int i = tid; i < 65536 / 4; i += NTHR) ((LAS unsigned*)lds)[i] = 0u;
    __syncthreads();
    pass2<1>(lds, kbase, g, t0, qf, lo4, hi4, wave, r, h2);
    __syncthreads();
    {
        const int q = tid >> 4, i = tid & 15;
        const LAS unsigned long long* cq = (const LAS unsigned long long*)(lds + OFF2_CAND) + q * CAP2;
        const int n = (int)((const LAS unsigned*)(lds + OFF2_CNT))[q], need = ((const LAS int*)(lds + OFF2_NEED))[q];
        for (int a_ = i; a_ < n; a_ += 16) {
            const unsigned long long mine = cq[a_];
            int rank = 0;
            const int n8 = (n + 7) & ~7;
            for (int j = 0; j < n8; j += 8) {
                unsigned long long cj[8];
#pragma unroll
                for (int k = 0; k < 8; ++k) cj[k] = cq[j + k];
#pragma unroll
                for (int k = 0; k < 8; ++k) rank += (cj[k] > mine) ? 1 : 0;
            }
            if (rank < need) { const int idx = 8191 - (int)(mine & 8191ull); atomicOr((unsigned*)&gtm[q * HROW + (idx >> 5)], 1u << (idx & 31)); }
        }
    }
    __syncthreads();
    write_mask_T(gtm, maskg, b, t0, tid);
    __syncthreads();
    return true;
}
}

struct Args {
    const float* in[22];
    float* out;
    unsigned char* ws;
    int ph_lo, ph_hi;
};

struct ColMap {
    int nseg; int d0[10], s0[10], len[10];
    __device__ __forceinline__ int src(int n) const {
        int r = -1;
#pragma unroll
        for (int i = 0; i < 10; ++i) if (i < nseg && n >= d0[i] && n < d0[i] + len[i]) r = s0[i] + (n - d0[i]);
        return r;
    }
};
__device__ __forceinline__ void conv_weight(const float* W, int K, int Nsrc, bf16* Bt, int Ndst, const float* gain, const ColMap& cm,
                                            LAS float* scr, int gw, int ngw, int lane) {
    const int nblk = Ndst / 32, kblk = K / 64;
    for (int it = gw; it < nblk * kblk; it += ngw) {
        const int kb = it / nblk, nb = it % nblk, k0 = kb * 64, n0 = nb * 32;
        const int sc = cm.src(n0 + (lane & 31));
#pragma unroll 8
        for (int i = 0; i < 32; ++i) {
            const int kk = 2 * i + (lane >> 5);
            float v = 0.f;
            if (sc >= 0) v = W[(size_t)(k0 + kk) * Nsrc + sc] * (gain ? gain[k0 + kk] : 1.0f);
            scr[kk * 33 + (lane & 31)] = v;
        }
        WAVE_LDS_SYNC();
        const int c = lane & 7;
#pragma unroll
        for (int j = 0; j < 4; ++j) {
            const int n = (lane >> 3) + 8 * j;
            const LAS float* s = scr + (8 * c) * 33 + n;
            u32x4 o; o.x = pk2(s[0 * 33], s[1 * 33]); o.y = pk2(s[2 * 33], s[3 * 33]); o.z = pk2(s[4 * 33], s[5 * 33]); o.w = pk2(s[6 * 33], s[7 * 33]);
            *(u32x4*)(Bt + (size_t)(n0 + n) * K + k0 + 8 * c) = o;
        }
        WAVE_LDS_SYNC();
    }
}

template <int PH>
__device__ __forceinline__ void mk_body(const Args& a) {
    extern __shared__ __attribute__((aligned(16))) unsigned char lds_raw[];
    LAS unsigned char* lds = (LAS unsigned char*)lds_raw;
    const int wave = __builtin_amdgcn_readfirstlane((int)threadIdx.x >> 6);
#define LANE_TID() const int lane = lane_id_v(), tid = wave * 64 + lane; (void)tid; (void)lane
    const int G = gridDim.x, bid = blockIdx.x;
    const int gw = bid * 8 + wave, ngw = G * 8;
    unsigned char* ws = a.ws;
    const float* x_in = a.in[0];
    float* xres = a.out;
#define Wt_in0 ((bf16*)(ws + WS_WIN0))
#define Wt_out0 ((bf16*)(ws + WS_WOUT0))
#define Wt_gu0 ((bf16*)(ws + WS_WGU0))
#define Wt_dn0 ((bf16*)(ws + WS_WDN0))
#define Wt_in1 ((bf16*)(ws + WS_WIN1))
#define Wt_uq ((bf16*)(ws + WS_WUQ))
#define Wt_ukv ((bf16*)(ws + WS_WUKV))
#define Wt_out1 ((bf16*)(ws + WS_WOUT1))
#define Wt_gu1 ((bf16*)(ws + WS_WGU1))
#define Wt_dn1 ((bf16*)(ws + WS_WDN1))
#define rope_cos ((float*)(ws + WS_ROPE))
#define rope_sin (((float*)(ws + WS_ROPE) + S * 16))
#define bucket_tab ((int*)(ws + WS_TAB))
#define maskg ((unsigned*)(ws + WS_MASK))
#define sqa ((float*)(ws + WS_SQA))
#define sqb ((float*)(ws + WS_SQB))
#define aux ((float*)(ws + WS_AUX))
#define lcum ((float*)(ws + WS_LC))
#define ssq ((float*)(ws + WS_SSQ))
#define krope ((bf16*)(ws + WS_KR))
#define xb ((bf16*)(ws + WS_XB))
#define mixed ((bf16*)(ws + WS_MIX))
#define y0 ((bf16*)(ws + WS_BIG))
#define hidden ((bf16*)(ws + WS_BIG))
#define y1 ((bf16*)(ws + WS_Y1))
#define mq ((bf16*)(ws + WS_MQ))
#define mkv ((bf16*)(ws + WS_MKV))
    const float* t5 = a.in[17];
    unsigned* ctl = (unsigned*)(ws + WS_CTL);
    const int lo = a.ph_lo, hi = a.ph_hi;
    XcdBarrier bar; bar.bar = (unsigned*)(ws + WS_CTL) + CW_BAR; bar.x = 0; bar.st = nullptr; bar.wave = wave;
    if (PH < 0) {
        volatile LAS unsigned* stw = (volatile LAS unsigned*)(lds + LDS_CTL_OFF);
        { LANE_TID(); if (tid < 16) stw[tid] = 0u; }
        __syncthreads();
        bar = xcd_barrier_post((unsigned*)(ws + WS_CTL) + CW_BAR, stw, wave);
    }
#define SEAM() do { if (PH < 0) xcd_barrier(bar); } while (0)
#define IN(k) (PH < 0 ? (lo <= (k) && (k) < hi) : (PH == (k)))

    if (IN(0)) {
        LANE_TID();
        LAS float* scr = (LAS float*)lds + wave * (64 * 33);
        {
            ColMap cm; cm.nseg = 10;
            const int d0[10] = {Y0_FQ, Y0_FK, Y0_FV, Y0_DQ, Y0_DK, Y0_DV, Y0_IQ, Y0_IK, Y0_FF, Y0_IW};
            const int s0[10] = {0, 512, 1024, 1544, 2056, 2568, 3080, 3336, 1536, 3400};
            const int ln[10] = {512, 512, 512, 512, 512, 512, 256, 64, 8, 4};
#pragma unroll
            for (int i = 0; i < 10; ++i) { cm.d0[i] = d0[i]; cm.s0[i] = s0[i]; cm.len[i] = ln[i]; }
            conv_weight(a.in[3], D, EVEN_IN, Wt_in0, Y0P, a.in[1], cm, scr, gw, ngw, lane);
        }
        {
            ColMap cm; cm.nseg = 1; cm.d0[0] = 0; cm.s0[0] = 0;
#pragma unroll
            for (int i = 1; i < 10; ++i) { cm.d0[i] = 0; cm.s0[i] = 0; cm.len[i] = 0; }
            cm.len[0] = D;
            conv_weight(a.in[5], D, D, Wt_out0, D, nullptr, cm, scr, gw, ngw, lane);
            conv_weight(a.in[16], D, D, Wt_out1, D, nullptr, cm, scr, gw, ngw, lane);
            conv_weight(a.in[20], FFH, D, Wt_dn0, D, nullptr, cm, scr, gw, ngw, lane);
            conv_weight(a.in[20] + (size_t)FFH * D, FFH, D, Wt_dn1, D, nullptr, cm, scr, gw, ngw, lane);
            cm.len[0] = ODD_IN;
            conv_weight(a.in[6], D, ODD_IN, Wt_in1, Y1P, a.in[1] + D, cm, scr, gw, ngw, lane);
            cm.len[0] = 768;
            conv_weight(a.in[13], 256, 768, Wt_uq, 768, a.in[12], cm, scr, gw, ngw, lane);
            cm.len[0] = 1024;
            conv_weight(a.in[15], 128, 1024, Wt_ukv, 1024, a.in[14], cm, scr, gw, ngw, lane);
        }
        {
            const int tiles_per = (D / 64) * 4;
            for (int it = gw; it < 88 * tiles_per; it += ngw) {
                const int slab = it / tiles_per, tt = it % tiles_per;
                const int layer = slab / 44, j = (slab % 44) >> 1, up = slab & 1;
                const float* W = (up ? a.in[19] : a.in[18]) + (size_t)layer * D * FFH;
                bf16* Bt = (layer ? Wt_gu1 : Wt_gu0) + (size_t)(256 * j + 128 * up) * D;
                const float* gain = a.in[2] + layer * D;
                const int kb = tt / 4, nb = tt % 4, k0 = kb * 64, n0 = nb * 32;
                const int sc = 128 * j + n0 + (lane & 31);
#pragma unroll 8
                for (int i = 0; i < 32; ++i) { const int kk = 2 * i + (lane >> 5); scr[kk * 33 + (lane & 31)] = W[(size_t)(k0 + kk) * FFH + sc] * gain[k0 + kk]; }
                WAVE_LDS_SYNC();
                const int c = lane & 7;
#pragma unroll
                for (int jj = 0; jj < 4; ++jj) {
                    const int n = (lane >> 3) + 8 * jj;
                    const LAS float* sp = scr + (8 * c) * 33 + n;
                    u32x4 ov; ov.x = pk2(sp[0 * 33], sp[1 * 33]); ov.y = pk2(sp[2 * 33], sp[3 * 33]); ov.z = pk2(sp[4 * 33], sp[5 * 33]); ov.w = pk2(sp[6 * 33], sp[7 * 33]);
                    *(u32x4*)(Bt + (size_t)(n0 + n) * D + k0 + 8 * c) = ov;
                }
                WAVE_LDS_SYNC();
            }
        }
        for (int m0 = gw * 4; m0 < M; m0 += ngw * 4) {
            f32x4 v[4][4];
#pragma unroll
            for (int rr_ = 0; rr_ < 4; ++rr_)
#pragma unroll
                for (int j = 0; j < 4; ++j) v[rr_][j] = ((const f32x4*)(x_in + (size_t)(m0 + rr_) * D) + lane)[64 * j];
#pragma unroll
            for (int rr_ = 0; rr_ < 4; ++rr_) {
                unsigned long long* o8 = (unsigned long long*)(xb + (size_t)(m0 + rr_) * D) + lane;
                float s = 0.f;
#pragma unroll
                for (int j = 0; j < 4; ++j) {
                    const f32x4 w_ = v[rr_][j];
                    s += (w_.x * w_.x + w_.y * w_.y) + (w_.z * w_.z + w_.w * w_.w);
                    o8[64 * j] = (unsigned long long)pk2(w_.x, w_.y) | ((unsigned long long)pk2(w_.z, w_.w) << 32);
                }
                s = wave_sum(s);
                if (lane < 16) ssq[(size_t)(m0 + rr_) * 16 + lane] = (lane == 0) ? s : 0.f;
            }
        }
        for (int i = bid * NTHR + tid; i < S * 16; i += G * NTHR) {
            const int pos = i >> 4, j = i & 15;
            const float inv = powf(10000.0f, -(float)(2 * j) / 32.0f);
            const float ang = (float)pos * inv;
            rope_cos[i] = cosf(ang); rope_sin[i] = sinf(ang);
        }
        if (bid == 0 && tid < 128) bucket_tab[tid] = t5_bucket_dev(tid);
    }

    SEAM();
    if (IN(1)) {
        pg8::Gemm g{xb, Wt_in0, M, Y0P, D, D, D}; pg8::StaticOrder So; So.init(M, Y0P, G, bid);
        pg8::EpiScale E{y0, Y0P, ssq, aux, 13, nullptr, -1, nullptr, -1};
        pg8::gemm_phase<pg8::EpiScale, pg8::StaticOrder, true, true>(lds, g, So, E, wave);
    }
    SEAM();
    if (IN(2)) {
        LANE_TID();
        for (int seq = bid; seq < NB * 8; seq += G) {
            const int b = seq >> 3, h = seq & 7;
            const float bf = a.in[4][h];
            const size_t r0 = (size_t)b * S + tid * 16;
            float v[16]; float run = 0.f;
#pragma unroll
            for (int i = 0; i < 16; ++i) {
                const float z = aux[(r0 + i) * 16 + h] + bf;
                run += fminf(z, 0.f) - log1pf(expf(-fabsf(z)));
                v[i] = run;
            }
            float incl = run;
#pragma unroll
            for (int o = 1; o < 64; o <<= 1) { const float t = __shfl_up(incl, o); if (lane >= o) incl += t; }
            LAS float* wtot = (LAS float*)lds;
            if (lane == 63) wtot[wave] = incl;
            __syncthreads();
            float off = incl - run;
            for (int w_ = 0; w_ < wave; ++w_) off += wtot[w_];
#pragma unroll
            for (int i = 0; i < 16; ++i) lcum[(r0 + i) * 8 + h] = off + v[i];
            __syncthreads();
        }
        for (int blk = gw; blk < M / 32; blk += ngw) {
            float mx2 = 0.f;
            for (int i = 0; i < 32; ++i) {
                const u32x4 v = *(const u32x4*)(y0 + (size_t)(blk * 32 + i) * Y0P + Y0_FK + 8 * lane);
                float s = 0.f;
#pragma unroll
                for (int j = 0; j < 4; ++j) { const float lo_ = __uint_as_float(v[j] << 16), hi_ = __uint_as_float(v[j] & 0xffff0000u); s = fmaf(lo_, lo_, s); s = fmaf(hi_, hi_, s); }
                s += __shfl_xor(s, 1); s += __shfl_xor(s, 2); s += __shfl_xor(s, 4);
                mx2 = fmaxf(mx2, s);
            }
            if ((lane & 7) == 0) atomicMax(ctl + CW_KMAX + ((blk * 32) / S) * 8 + (lane >> 3), __float_as_uint(mx2));
        }
    }

    SEAM();
    if (IN(3)) {
        LANE_TID();
        const int lane_o = opaque_i(lane); const int rr = lane_o & 31, hh = lane_o >> 5;
        att::QPre qp{nullptr, 0u, false};
        for (;;) {
            const int u = att::next_unit_pre(qp, ctl + CW_Q + 0 * 512, 256, lds, att::OFF_MISC, wave);
            if (u < 0) break;
            const int b = u >> 8, h = 2 * ((u >> 6) & 3) + ((u >> 4) & 1), qb = ((u >> 5) & 1) ? 15 - (u & 15) : 31 - (u & 15);
            att::Tens T{};
            T.Q = y0 + Y0_FQ + h * 64; T.ldq = Y0P; T.K = y0 + Y0_FK + h * 64; T.ldk = Y0P; T.V = y0 + Y0_FV + h * 64; T.ldv = Y0P;
            T.lc = lcum + h; T.scale2 = 0.125f * att::LOG2E;
            T.kmaxn = sqrtf(__uint_as_float(__hip_atomic_load(ctl + CW_KMAX + b * 8 + h, __ATOMIC_RELAXED, __HIP_MEMORY_SCOPE_AGENT)));
            att::f32x16 o[2]; float l;
            att::attn_pass<att::AM_FOX, 64, 64>(lds, T, (size_t)b * S, qb * 256, o, l, wave, &qp);
            att::store_o<64>(mixed + ((size_t)b * S + qb * 256 + wave * 32 + rr) * D + h * 64, o, l, hh);
        }
    }
    if (IN(4)) {
        LANE_TID();
        for (;;) {
            const int u = att::next_unit(ctl + CW_Q + 4 * 512, 256, lds, dsa::OFF_SLOT, wave);
            if (u < 0) break;
            const int b = u >> 8, g = 255 - (u & 255);
            if (!dsa::run_unit2(lds, y0, aux, maskg, b, g, tid, wave, lane))
                dsa::run_unit(lds, y0, aux, maskg, b, g, tid, wave, lane);
        }
    }
    SEAM();
    if (IN(19)) {
        att::QPre qp{nullptr, 0u, false};
        for (;;) {
            const int u = att::next_unit_pre(qp, ctl + CW_Q + 1 * 512, 256, lds, att::OFF_MISC, wave);
            if (u < 0) break;
            const int b = u >> 8, h = (u >> 5) & 7, qb = 31 - (u & 31);
            { const int t_ = wave * 64 + lane_id_v();
              if (t_ <= 128) ((LAS float*)(lds + att::OFF_LUT))[t_] = (t_ < 128) ? (t5[bucket_tab[t_] * 8 + h] - t5[31 * 8 + h]) * att::LOG2E : 0.f;
              if (t_ >= 192 && t_ < 256) { const int e_ = (t_ - 192) >> 2, c_ = t_ & 3; ((LAS float*)(lds + att::OFF_LUT + 768))[t_ - 192] = ((e_ >> c_) & 1) ? 0.f : -INFINITY; } }
            att::Tens T{};
            T.Q = y0 + Y0_DQ + h * 64; T.ldq = Y0P; T.K = y0 + Y0_DK + h * 64; T.ldk = Y0P; T.V = y0 + Y0_DV + h * 64; T.ldv = Y0P;
            T.mask = maskg; T.scale2 = 0.125f * att::LOG2E;
            att::f32x16 o[2]; float l;
            att::attn_pass<att::AM_DSA, 64, 64>(lds, T, (size_t)b * S, qb * 256, o, l, wave, &qp);
            const int lane_o = lane_id_v(); const int rr = lane_o & 31, hh = lane_o >> 5;
            att::store_o<64>(mixed + ((size_t)b * S + qb * 256 + wave * 32 + rr) * D + 512 + h * 64, o, l, hh);
        }
    }
    SEAM();
    if (IN(5)) {
        pg8::Gemm g{mixed, Wt_out0, M, D, D, D, D}; pg8::StaticOrder So; So.init(M, D, G, bid);
        pg8::EpiResid<true, false> E{nullptr, nullptr, xb, ssq};
        pg8::gemm_phase<pg8::EpiResid<true, false>, pg8::StaticOrder, true, true>(lds, g, So, E, wave);
    }

    SEAM();

    if (IN(7)) {
        pg8::Gemm g{xb, Wt_gu0, M, 2 * FFH, D, D, D}; pg8::StaticOrder So; So.init(M, 2 * FFH, G, bid);
        pg8::EpiGU E{hidden, FFH, ssq};
        pg8::gemm_phase<pg8::EpiGU, pg8::StaticOrder, true, true>(lds, g, So, E, wave);
    }
    SEAM();
    if (IN(8)) {
        pg8::Gemm g{hidden, Wt_dn0, M, D, FFH, FFH, FFH}; pg8::StaticOrder So; So.init(M, D, G, bid);
        pg8::EpiResid<true, false> E{nullptr, nullptr, xb, ssq};
        pg8::gemm_phase<pg8::EpiResid<true, false>, pg8::StaticOrder, true, true>(lds, g, So, E, wave);
    }
    SEAM();

    if (IN(10)) {
        pg8::Gemm g{xb, Wt_in1, M, Y1P, D, D, D}; pg8::StaticOrder So; So.init(M, Y1P, G, bid);
        pg8::EpiScale E{y1, Y1P, ssq, nullptr, -1, sqa, 6, sqb, 7};
        pg8::gemm_phase<pg8::EpiScale, pg8::StaticOrder, true, true>(lds, g, So, E, wave);
    }

    SEAM();
    if (IN(11)) {
        LANE_TID();
        {
            pg8::Gemm g{y1 + Y1_MCQ, Wt_uq, M, MQP, 256, Y1P, 256}; pg8::StaticOrder So; So.init(M, MQP, G, bid);
            pg8::EpiMkv E{mq, MQP, sqa, 1.0f / 256.0f};
            pg8::gemm_phase<pg8::EpiMkv, pg8::StaticOrder, true, true>(lds, g, So, E, wave);
        }
        {
            pg8::Gemm g{y1 + Y1_MCKV, Wt_ukv, M, MKVP, 128, Y1P, 128}; pg8::StaticOrder So; So.init(M, MKVP, G, bid);
            pg8::EpiMkv E{mkv, MKVP, sqb, 1.0f / 128.0f};
            pg8::gemm_phase<pg8::EpiMkv, pg8::StaticOrder, true, true>(lds, g, So, E, wave);
        }
        for (int it = bid * NTHR + tid; it < M * 16; it += G * NTHR) {
            const int m = it >> 4, i = it & 15, t = m & (S - 1);
            const float x1 = bf2f(y1[(size_t)m * Y1P + Y1_MKR + i]), x2 = bf2f(y1[(size_t)m * Y1P + Y1_MKR + 16 + i]);
            const float cs = rope_cos[t * 16 + i], sn = rope_sin[t * 16 + i];
            krope[(size_t)m * 32 + i] = f2bf(x1 * cs - x2 * sn);
            krope[(size_t)m * 32 + 16 + i] = f2bf(x2 * cs + x1 * sn);
        }
    }
    SEAM();
    if (IN(12)) {
        LANE_TID();
        att::QPre qp{nullptr, 0u, false};
        float lam;
        {
            float s1 = 0.f, s2 = 0.f;
            for (int i = 0; i < 64; ++i) { s1 += a.in[7][i] * a.in[8][i]; s2 += a.in[9][i] * a.in[10][i]; }
            lam = expf(s1) - expf(s2) + LAMBDA_INIT;
        }
        for (;;) {
            const int u = att::next_unit_pre(qp, ctl + CW_Q + 2 * 512, 128, lds, att::OFF_MISC, wave);
            if (u < 0) break;
            const int b = u >> 7, h = (u >> 5) & 3, qb = 31 - (u & 31);
            att::f32x16 oa[4];
#pragma unroll 1
            for (int mp = 0; mp < 2; ++mp) {
                const int mh = 2 * h + mp;
                { const int t_ = wave * 64 + lane_id_v(); if (t_ <= 128) ((LAS float*)(lds + att::OFF_LUT))[t_] = (t_ < 128) ? (t5[bucket_tab[t_] * 8 + mh] - t5[31 * 8 + mh]) * att::LOG2E : 0.f; }
                att::Tens T{};
                T.Q = y1 + Y1_CQ + mh * 64; T.ldq = Y1P; T.K = y1 + Y1_CK + mh * 64; T.ldk = Y1P; T.V = y1 + Y1_CV + h * 128; T.ldv = Y1P;
                T.scale2 = 0.125f * att::LOG2E;
                float l;
                att::attn_pass<att::AM_DIFF, 64, 128>(lds, T, (size_t)b * S, qb * 256, oa, l, wave);
                const float il = 1.0f / l;
                const int lane_s = lane_id_v();
                bf16* stash = mixed + ((size_t)b * S + qb * 256 + wave * 32 + (lane_s & 31)) * D + h * 128 + 8 * (lane_s >> 5);
                if (mp == 0) {
#pragma unroll
                    for (int db = 0; db < 4; ++db)
#pragma unroll
                        for (int gp = 0; gp < 2; ++gp) { u32x2 a_, b_;
                            a_.x = pg8::cvt_pk_bf16(oa[db][8 * gp] * il, oa[db][8 * gp + 1] * il); a_.y = pg8::cvt_pk_bf16(oa[db][8 * gp + 2] * il, oa[db][8 * gp + 3] * il);
                            b_.x = pg8::cvt_pk_bf16(oa[db][8 * gp + 4] * il, oa[db][8 * gp + 5] * il); b_.y = pg8::cvt_pk_bf16(oa[db][8 * gp + 6] * il, oa[db][8 * gp + 7] * il);
                            att::swap_pair(a_, b_);
                            const u32x4 w_ = {a_.x, a_.y, b_.x, b_.y}; *(u32x4*)(stash + 32 * db + 16 * gp) = w_; }
                } else {
                    const float c2 = lam * il;
#pragma unroll
                    for (int db = 0; db < 4; ++db)
#pragma unroll
                        for (int gp = 0; gp < 2; ++gp) { const u32x4 w_ = *(const u32x4*)(stash + 32 * db + 16 * gp);
                            u32x2 a_ = {w_.x, w_.y}, b_ = {w_.z, w_.w};
                            att::swap_pair(a_, b_);
                            const float v[8] = {__uint_as_float(a_.x << 16), __uint_as_float(a_.x & 0xffff0000u), __uint_as_float(a_.y << 16), __uint_as_float(a_.y & 0xffff0000u),
                                                __uint_as_float(b_.x << 16), __uint_as_float(b_.x & 0xffff0000u), __uint_as_float(b_.y << 16), __uint_as_float(b_.y & 0xffff0000u)};
#pragma unroll
                            for (int i = 0; i < 8; ++i) oa[db][8 * gp + i] = v[i] - oa[db][8 * gp + i] * c2; }
                }
            }
            const int lane_o = lane_id_v(); const int rr = lane_o & 31, hh = lane_o >> 5;
            float ss = 0.f;
#pragma unroll
            for (int db = 0; db < 4; ++db)
#pragma unroll
                for (int rg = 0; rg < 16; ++rg) ss += oa[db][rg] * oa[db][rg];
            ss += __shfl_xor(ss, 32);
            const float rn = (1.0f / sqrtf(ss * (1.0f / 128.0f) + RMS_EPS)) * (1.0f - LAMBDA_INIT);
            bf16* orow = mixed + ((size_t)b * S + qb * 256 + wave * 32 + rr) * D + h * 128;
#pragma unroll
            for (int db = 0; db < 4; ++db)
#pragma unroll
                for (int gp = 0; gp < 2; ++gp) {
                    const int d0 = 32 * db + 16 * gp + 4 * hh;
                    const f32x4 g0 = *(const f32x4*)(a.in[11] + d0), g1 = *(const f32x4*)(a.in[11] + d0 + 8);
                    u32x2 a_, b_;
                    a_.x = pg8::cvt_pk_bf16(oa[db][8 * gp + 0] * rn * g0.x, oa[db][8 * gp + 1] * rn * g0.y); a_.y = pg8::cvt_pk_bf16(oa[db][8 * gp + 2] * rn * g0.z, oa[db][8 * gp + 3] * rn * g0.w);
                    b_.x = pg8::cvt_pk_bf16(oa[db][8 * gp + 4] * rn * g1.x, oa[db][8 * gp + 5] * rn * g1.y); b_.y = pg8::cvt_pk_bf16(oa[db][8 * gp + 6] * rn * g1.z, oa[db][8 * gp + 7] * rn * g1.w);
                    att::swap_pair(a_, b_);
                    const u32x4 w = {a_.x, a_.y, b_.x, b_.y};
                    *(u32x4*)(orow + 32 * db + 16 * gp + 8 * hh) = w;
                }
        }
    }
    if (IN(13)) {
        LANE_TID();
        const int lane_o = opaque_i(lane); const int rr = lane_o & 31, hh = lane_o >> 5;
        att::QPre qp{nullptr, 0u, false};
        for (;;) {
            const int u = att::next_unit_pre(qp, ctl + CW_Q + 3 * 512, 256, lds, att::OFF_MISC, wave);
            if (u < 0) break;
            const int b = u >> 8, h = (u >> 5) & 7, qb = 31 - (u & 31);
            att::Tens T{};
            T.Q = mq + h * 96; T.ldq = MQP; T.K = mkv + h * 128; T.ldk = MKVP; T.K2 = krope; T.ldk2 = 32; T.rcos = rope_cos; T.rsin = rope_sin; T.V = mkv + h * 128 + 64; T.ldv = MKVP;
            T.scale2 = 0.10206207261596575f * att::LOG2E;
            att::f32x16 o[2]; float l;
            att::attn_pass<att::AM_MLA, 96, 64>(lds, T, (size_t)b * S, qb * 256, o, l, wave, &qp);
            att::store_o<64>(mixed + ((size_t)b * S + qb * 256 + wave * 32 + rr) * D + 512 + h * 64, o, l, hh);
        }
    }
    SEAM();
    if (IN(14)) {
        pg8::Gemm g{mixed, Wt_out1, M, D, D, D, D}; pg8::StaticOrder So; So.init(M, D, G, bid);
        pg8::EpiResid<true, false> E{nullptr, nullptr, xb, ssq};
        pg8::gemm_phase<pg8::EpiResid<true, false>, pg8::StaticOrder, true, true>(lds, g, So, E, wave);
    }
    SEAM();
    if (IN(16)) {
        pg8::Gemm g{xb, Wt_gu1, M, 2 * FFH, D, D, D}; pg8::StaticOrder So; So.init(M, 2 * FFH, G, bid);
        pg8::EpiGU E{hidden, FFH, ssq};
        pg8::gemm_phase<pg8::EpiGU, pg8::StaticOrder, true, true>(lds, g, So, E, wave);
    }
    SEAM();
    if (IN(17)) {
        pg8::Gemm g{hidden, Wt_dn1, M, D, FFH, FFH, FFH}; pg8::StaticOrder So; So.init(M, D, G, bid);
        pg8::EpiResid<true, false> E{nullptr, nullptr, xb, ssq};
        pg8::gemm_phase<pg8::EpiResid<true, false>, pg8::StaticOrder, true, true>(lds, g, So, E, wave);
    }
    SEAM();

    if (IN(18)) {
        const float* fg = a.in[21];
        const int lane = lane_id_v();
        f32x4 gv[4];
#pragma unroll
        for (int j = 0; j < 2; ++j) { gv[2 * j] = *(const f32x4*)(fg + 512 * j + 8 * lane); gv[2 * j + 1] = *(const f32x4*)(fg + 512 * j + 8 * lane + 4); }
        for (int m0 = gw * 4; m0 < M; m0 += ngw * 4) {
            u32x4 v[4][2]; float rsv[4];
#pragma unroll
            for (int rr_ = 0; rr_ < 4; ++rr_) {
                v[rr_][0] = *(const u32x4*)(xb + (size_t)(m0 + rr_) * D + 8 * lane); v[rr_][1] = *(const u32x4*)(xb + (size_t)(m0 + rr_) * D + 512 + 8 * lane);
                rsv[rr_] = pg8::row_scale16(ssq, m0 + rr_, 1.0f / 1024.0f);
            }
#pragma unroll
            for (int rr_ = 0; rr_ < 4; ++rr_) {
                float* orow = xres + (size_t)(m0 + rr_) * D;
                const float rs = rsv[rr_];
#pragma unroll
                for (int j = 0; j < 2; ++j) {
                    const u32x4 w = v[rr_][j];
                    const f32x4 lo_ = {__uint_as_float(w.x << 16), __uint_as_float(w.x & 0xffff0000u), __uint_as_float(w.y << 16), __uint_as_float(w.y & 0xffff0000u)};
                    const f32x4 hi_ = {__uint_as_float(w.z << 16), __uint_as_float(w.z & 0xffff0000u), __uint_as_float(w.w << 16), __uint_as_float(w.w & 0xffff0000u)};
                    *(f32x4*)(orow + 512 * j + 8 * lane) = lo_ * rs * gv[2 * j];
                    *(f32x4*)(orow + 512 * j + 8 * lane + 4) = hi_ * rs * gv[2 * j + 1];
                }
            }
        }
    }
#undef IN
#undef SEAM
#undef Wt_in0
#undef Wt_out0
#undef Wt_gu0
#undef Wt_dn0
#undef Wt_in1
#undef Wt_uq
#undef Wt_ukv
#undef Wt_out1
#undef Wt_gu1
#undef Wt_dn1
#undef rope_cos
#undef rope_sin
#undef bucket_tab
#undef maskg
#undef sqa
#undef sqb
#undef aux
#undef lcum
#undef ssq
#undef krope
#undef xb
#undef mixed
#undef y0
#undef hidden
#undef y1
#undef mq
#undef mkv
}
template <int PH>
__global__ void __launch_bounds__(NTHR, 2) mk_phase(Args a) { mk_body<PH>(a); }

constexpr int N_PHASES = 20;

extern "C" void kernel_launch(void* const* d_in, const int* in_sizes, int n_in, void* d_out, int out_size, void* d_ws, size_t ws_size, hipStream_t stream) {
    static int grid = 0;
    if (grid == 0) {
        if (n_in != 22 || out_size != M * D || ws_size < WS_END) { fprintf(stderr, "kernel_launch: unexpected sizes n_in %d out %d ws %zu\n", n_in, out_size, ws_size); grid = -1; return; }
        int dev = 0, cus = 0, per_cu = 0;
        if (hipGetDevice(&dev) != hipSuccess || hipDeviceGetAttribute(&cus, hipDeviceAttributeMultiprocessorCount, dev) != hipSuccess) { grid = -1; return; }
        if (hipFuncSetAttribute((const void*)mk_phase<-1>, hipFuncAttributeMaxDynamicSharedMemorySize, LDS_BYTES) != hipSuccess) { grid = -1; return; }
        if (hipOccupancyMaxActiveBlocksPerMultiprocessor(&per_cu, (const void*)mk_phase<-1>, NTHR, LDS_BYTES) != hipSuccess || per_cu < 1) { fprintf(stderr, "kernel_launch: occupancy query says %d\n", per_cu); (void)hipGetLastError(); grid = -1; return; }
        grid = cus;
    }
    if (grid < 0) return;
    (void)hipMemsetAsync((char*)d_ws + WS_CTL, 0, 1 * MiB, stream);
    Args a{};
    for (int i = 0; i < 22; ++i) a.in[i] = (const float*)d_in[i];
    a.out = (float*)d_out; a.ws = (unsigned char*)d_ws;
    a.ph_lo = 0; a.ph_hi = N_PHASES;
    hipLaunchKernelGGL(mk_phase<-1>, dim3(grid), dim3(NTHR), LDS_BYTES, stream, a);
}
```
